# Optimizing an MI355X kernel written in HIP

```python
import jax, jax.numpy as jnp
from jax import lax
import numpy as np

D_MODEL = 1024
BATCH = 4
SEQ = 4096
DEPTH = 4

MLA_HEADS = 8
MLA_NOPE = 64
MLA_ROPE = 32
MLA_V = 64
MLA_Q_LORA = 256
MLA_KV_LORA = 128
ROPE_THETA = 10000.0
ATTN_BLOCK = 128
SG_HEADS = 4
SG_HEAD_DIM = 64
SG_CHUNK = 128
GLA_HEADS = 4
GLA_DK = 32
GLA_DV = 64
GLA_GATE_RANK = 16
GLA_GATE_TAU = 16.0
GLA_CHUNK = 64
D_FF = 2816
CONV_WIDTH = 3
EPS = 1e-6

D_MLA = MLA_HEADS * MLA_V
D_SG = SG_HEADS * SG_HEAD_DIM
D_GLA = GLA_HEADS * GLA_DV
D_MIX = D_MLA + D_SG + D_GLA
SPLIT_SIZES = (MLA_Q_LORA, MLA_KV_LORA, MLA_ROPE, D_SG, D_SG, GLA_HEADS * GLA_DK, GLA_HEADS * GLA_DK, D_GLA, GLA_GATE_RANK, D_GLA)
IN_COLS = 1712

kernel_name = 'hybrid_mla_sgu_gla_adaln_convffn'


def rms_norm(x, g):
    xf = x.astype(jnp.float32)
    y = xf * lax.rsqrt(jnp.mean(xf * xf, axis=-1, keepdims=True) + EPS)
    return (y * g.astype(jnp.float32)).astype(x.dtype)


def layer_norm(x, g, b):
    xf = x.astype(jnp.float32)
    mu = jnp.mean(xf, axis=-1, keepdims=True)
    var = jnp.mean(jnp.square(xf - mu), axis=-1, keepdims=True)
    return ((xf - mu) * lax.rsqrt(var + EPS) * g.astype(jnp.float32) + b.astype(jnp.float32)).astype(x.dtype)


def rope_tables(positions):
    inv_freq = ROPE_THETA ** (-jnp.arange(0, MLA_ROPE, 2, dtype=jnp.float32) / MLA_ROPE)
    ang = positions.astype(jnp.float32)[..., None] * inv_freq
    return jnp.cos(ang), jnp.sin(ang)


def apply_rope(t, cos, sin):
    t1, t2 = jnp.split(t, 2, axis=-1)
    return jnp.concatenate([t1 * cos - t2 * sin, t1 * sin + t2 * cos], axis=-1).astype(t.dtype)


def mla_attention(c_q, c_kv, k_rope_raw, q_norm_g, kv_norm_g, w_uq, w_ukv, cos, sin):
    B, S, _ = c_q.shape
    c_q = rms_norm(c_q, q_norm_g)
    c_kv = rms_norm(c_kv, kv_norm_g)
    q = (c_q @ w_uq).reshape(B, S, MLA_HEADS, MLA_NOPE + MLA_ROPE)
    q_nope = q[..., :MLA_NOPE]
    q_rope = apply_rope(q[..., MLA_NOPE:], cos[:, :, None, :], sin[:, :, None, :])
    kv = (c_kv @ w_ukv).reshape(B, S, MLA_HEADS, MLA_NOPE + MLA_V)
    k_nope = kv[..., :MLA_NOPE]
    v = kv[..., MLA_NOPE:]
    k_rope = apply_rope(k_rope_raw, cos, sin)
    scale = (MLA_NOPE + MLA_ROPE) ** -0.5
    nb = S // ATTN_BLOCK
    k_idx = jnp.arange(S)

    def to_blocks(t):
        return jnp.moveaxis(t.reshape(B, nb, ATTN_BLOCK, *t.shape[2:]), 1, 0)

    def attend(args):
        qn, qr, blk = args
        s = jnp.einsum('bqhd,bkhd->bhqk', qn, k_nope) + jnp.einsum('bqhd,bkd->bhqk', qr, k_rope)
        q_idx = blk * ATTN_BLOCK + jnp.arange(ATTN_BLOCK)
        causal = q_idx[:, None] >= k_idx[None, :]
        s = jnp.where(causal, s.astype(jnp.float32) * scale, -jnp.inf)
        p = jax.nn.softmax(s, axis=-1).astype(v.dtype)
        return jnp.einsum('bhqk,bkhd->bqhd', p, v)

    o = lax.map(attend, (to_blocks(q_nope), to_blocks(q_rope), jnp.arange(nb)))
    return jnp.moveaxis(o, 0, 1).reshape(B, S, D_MLA)


def spatial_gating(u, v, ln_g, ln_b, w_s, b_s):
    B, S, _ = u.shape
    u = jax.nn.gelu(u)
    v = layer_norm(jax.nn.gelu(v), ln_g, ln_b)
    nc = S // SG_CHUNK
    v = v.reshape(B, nc, SG_CHUNK, SG_HEADS, SG_HEAD_DIM)
    causal = jnp.tril(jnp.ones((SG_CHUNK, SG_CHUNK), dtype=bool))
    w = jnp.where(causal[None], w_s, 0).astype(v.dtype)
    mixed = jnp.einsum('hts,bnshd->bnthd', w, v) + b_s.T[None, None, :, :, None]
    return u * mixed.reshape(B, S, D_SG)


def gla(q, k, v, gate_lr, r, w_gate2, b_gate, norm_g):
    B, S, _ = q.shape
    f32 = jnp.float32
    log_a = jax.nn.log_sigmoid((gate_lr @ w_gate2 + b_gate).astype(f32)) / GLA_GATE_TAU
    nc = S // GLA_CHUNK

    def heads(t, d):
        return t.reshape(B, nc, GLA_CHUNK, GLA_HEADS, d).transpose(1, 0, 3, 2, 4)

    qc = heads(q.astype(f32) * GLA_DK ** -0.5, GLA_DK)
    kc = heads(k.astype(f32), GLA_DK)
    vc = heads(v.astype(f32), GLA_DV)
    gc = heads(log_a, GLA_DK)
    causal = jnp.tril(jnp.ones((GLA_CHUNK, GLA_CHUNK), dtype=bool))[None, None, :, :, None]

    def step(state, inp):
        qi, ki, vi, gi = inp
        b = jnp.cumsum(gi, axis=2)
        o_inter = jnp.einsum('bhcd,bhdv->bhcv', qi * jnp.exp(b), state)
        diff = jnp.where(causal, b[:, :, :, None, :] - b[:, :, None, :, :], -jnp.inf)
        a = jnp.einsum('bhid,bhjd,bhijd->bhij', qi, ki, jnp.exp(diff))
        o_intra = jnp.einsum('bhij,bhjv->bhiv', a, vi)
        b_last = b[:, :, -1:, :]
        state = jnp.exp(b_last[:, :, 0, :])[..., None] * state + jnp.einsum('bhjd,bhjv->bhdv', ki * jnp.exp(b_last - b), vi)
        return state, o_inter + o_intra

    s0 = jnp.zeros((B, GLA_HEADS, GLA_DK, GLA_DV), f32)
    _, o = lax.scan(step, s0, (qc, kc, vc, gc))
    o = o.transpose(1, 0, 3, 2, 4).reshape(B, S, GLA_HEADS, GLA_DV)
    o = rms_norm(o, norm_g).reshape(B, S, D_GLA)
    return (o * jax.nn.silu(r.astype(f32))).astype(q.dtype)


def conv_ffn(h, w_up, conv_w, conv_b, w_down):
    S = h.shape[1]
    z = h @ w_up
    zp = jnp.pad(z, ((0, 0), (CONV_WIDTH - 1, 0), (0, 0)))
    zc = conv_b + conv_w[CONV_WIDTH - 1] * zp[:, CONV_WIDTH - 1:CONV_WIDTH - 1 + S]
    for i in range(CONV_WIDTH - 1):
        zc = zc + conv_w[i] * zp[:, i:i + S]
    val, gate = jnp.split(zc, 2, axis=-1)
    return (jax.nn.silu(gate) * val) @ w_down


def setup_inputs(seed: int = 0) -> dict:
    key = jax.random.key(seed)
    ks = jax.random.split(key, 26)
    f32 = jnp.float32
    nrm = lambda k, shape, s: jax.random.normal(k, shape, f32) * s
    gain = lambda k, shape: 1.0 + 0.02 * jax.random.normal(k, shape, f32)
    return {
        'x': nrm(ks[0], (BATCH, SEQ, D_MODEL), 1.0),
        'c': nrm(ks[1], (BATCH, D_MODEL), 1.0),
        'positions': jnp.broadcast_to(jnp.arange(SEQ, dtype=jnp.int32), (BATCH, SEQ)),
        'mod_w': nrm(ks[2], (DEPTH, D_MODEL, 6 * D_MODEL), 0.5 * D_MODEL ** -0.5),
        'mod_b': nrm(ks[3], (DEPTH, 6 * D_MODEL), 0.01),
        'norm_mix_g': gain(ks[4], (DEPTH, D_MODEL)),
        'norm_ffn_g': gain(ks[5], (DEPTH, D_MODEL)),
        'w_in': nrm(ks[6], (DEPTH, D_MODEL, IN_COLS), D_MODEL ** -0.5),
        'mla_q_norm_g': gain(ks[7], (DEPTH, MLA_Q_LORA)),
        'mla_kv_norm_g': gain(ks[8], (DEPTH, MLA_KV_LORA)),
        'mla_w_uq': nrm(ks[9], (DEPTH, MLA_Q_LORA, MLA_HEADS * (MLA_NOPE + MLA_ROPE)), MLA_Q_LORA ** -0.5),
        'mla_w_ukv': nrm(ks[10], (DEPTH, MLA_KV_LORA, MLA_HEADS * (MLA_NOPE + MLA_V)), MLA_KV_LORA ** -0.5),
        'sg_ln_g': gain(ks[11], (DEPTH, D_SG)),
        'sg_ln_b': nrm(ks[12], (DEPTH, D_SG), 0.02),
        'sg_w_s': nrm(ks[13], (DEPTH, SG_HEADS, SG_CHUNK, SG_CHUNK), SG_CHUNK ** -0.5),
        'sg_b_s': gain(ks[14], (DEPTH, SG_HEADS, SG_CHUNK)),
        'gla_w_gate2': nrm(ks[15], (DEPTH, GLA_GATE_RANK, GLA_HEADS * GLA_DK), GLA_GATE_RANK ** -0.5),
        'gla_b_gate': nrm(ks[16], (DEPTH, GLA_HEADS * GLA_DK), 0.02),
        'gla_norm_g': gain(ks[17], (DEPTH, GLA_DV)),
        'w_out': nrm(ks[18], (DEPTH, D_MIX, D_MODEL), D_MIX ** -0.5),
        'ffn_w_up': nrm(ks[19], (DEPTH, D_MODEL, 2 * D_FF), D_MODEL ** -0.5),
        'ffn_conv_w': nrm(ks[20], (DEPTH, CONV_WIDTH, 2 * D_FF), CONV_WIDTH ** -0.5),
        'ffn_conv_b': nrm(ks[21], (DEPTH, 2 * D_FF), 0.02),
        'ffn_w_down': nrm(ks[22], (DEPTH, D_FF, D_MODEL), D_FF ** -0.5),
        'final_norm_g': gain(ks[23], (D_MODEL,)),
    }


def reference(x, c, positions, mod_w, mod_b, norm_mix_g, norm_ffn_g, w_in, mla_q_norm_g, mla_kv_norm_g, mla_w_uq, mla_w_ukv, sg_ln_g, sg_ln_b, sg_w_s, sg_b_s, gla_w_gate2, gla_b_gate, gla_norm_g, w_out, ffn_w_up, ffn_conv_w, ffn_conv_b, ffn_w_down, final_norm_g):
    cos, sin = rope_tables(positions)
    split_points = [int(p) for p in np.cumsum(SPLIT_SIZES)[:-1]]
    c_act = jax.nn.silu(c)
    for l in range(DEPTH):
        mod = (c_act @ mod_w[l] + mod_b[l])[:, None, :]
        sh1, sc1, g1, sh2, sc2, g2 = jnp.split(mod, 6, axis=-1)
        h = rms_norm(x, norm_mix_g[l]) * (1.0 + sc1) + sh1
        z = h @ w_in[l]
        cq, ckv, kr, su, sv, gq, gk, gv, glr, gr = jnp.split(z, split_points, axis=-1)
        o_a = mla_attention(cq, ckv, kr, mla_q_norm_g[l], mla_kv_norm_g[l], mla_w_uq[l], mla_w_ukv[l], cos, sin)
        o_b = spatial_gating(su, sv, sg_ln_g[l], sg_ln_b[l], sg_w_s[l], sg_b_s[l])
        o_c = gla(gq, gk, gv, glr, gr, gla_w_gate2[l], gla_b_gate[l], gla_norm_g[l])
        mix = jnp.concatenate([o_a, o_b, o_c], axis=-1) @ w_out[l]
        x = x + g1 * mix
        h2 = rms_norm(x, norm_ffn_g[l]) * (1.0 + sc2) + sh2
        x = x + g2 * conv_ffn(h2, ffn_w_up[l], ffn_conv_w[l], ffn_conv_b[l], ffn_w_down[l])
    return rms_norm(x, final_norm_g)
```

```cpp
#include <hip/hip_runtime.h>
#include <hip/hip_cooperative_groups.h>
#include <cstdio>
#include <cstdint>
namespace cg = cooperative_groups;
__device__ __forceinline__ int ltid() { int t = threadIdx.x; asm volatile("" : "+v"(t)); return t; }
namespace pg8 {
#define PG8_LAS __attribute__((address_space(3)))
typedef unsigned short bf16_t;
typedef short bf16x8 __attribute__((ext_vector_type(8)));
typedef float f32x4 __attribute__((ext_vector_type(4)));
typedef unsigned u32x4 __attribute__((ext_vector_type(4)));
constexpr int BM = 256, BK = 64, HALF = 128, HTB = HALF * BK * 2  , STAGE_BYTES = 8 * HTB, NXCD = 8, WGM = 4;

__host__ __device__ __forceinline__ int lds_byte(int r, int c) { const int st = (r >> 4) * 2 + (c >> 5), rr = r & 15, cc = c & 31, ob = rr * 64 + cc * 2; return st * 1024 + (ob ^ (((ob >> 9) & 1) << 5)); }
__host__ __device__ __forceinline__ void stage_rc(int b, int& R, int& C) { const int st = b / 1024, sb = b % 1024, swz = sb ^ (((sb >> 9) & 1) << 5); R = (st >> 1) * 16 + swz / 64; C = (st & 1) * 32 + (swz % 64) / 2; }
__host__ __device__ __forceinline__ int perm32(int rho) { const int n = rho >> 4, i = rho & 15; return 8 * (i >> 2) + 4 * n + (i & 3); }

struct Unit { int pm, pn; };
struct Gemm { const bf16_t* A; const bf16_t* Bt; int M, N, K, lda; };

struct StaticOrder {
    int nM, nN, nwg, G, c;
    __host__ __device__ void init(int M, int N, int G_, int c_) { nM = M / BM; nN = N / BM; nwg = nM * nN; G = G_; c = c_; }
    __host__ __device__ bool next(int i, Unit& u) const {
        const long L = (long)i * G + c; if (L >= nwg) return false;
        int wgid = (int)L; { const int q = nwg / NXCD, r = nwg % NXCD, xcd = wgid % NXCD, off = wgid / NXCD; wgid = (xcd < r ? xcd * (q + 1) : r * (q + 1) + (xcd - r) * q) + off; }
        const int nig = WGM * nN, gid = wgid / nig, fm = gid * WGM, gsz = (nM - fm) < WGM ? (nM - fm) : WGM;
        u.pm = fm + ((wgid % nig) % gsz); u.pn = (wgid % nig) / gsz; return true;
    }
    __device__ __forceinline__ void a_ready(const Unit&) const {}
    __device__ __forceinline__ void done(const Unit&) const {}
};

__device__ __forceinline__ unsigned cvt_pk_bf16(float lo, float hi) { unsigned r; asm volatile("v_cvt_pk_bf16_f32 %0, %1, %2" : "=v"(r) : "v"(lo), "v"(hi)); return r; }
typedef float f32x2c_t __attribute__((ext_vector_type(2))); typedef __bf16 bf16x2c_t __attribute__((ext_vector_type(2)));
__device__ __forceinline__ unsigned cvt_pk_bf16_safe(float lo, float hi) { f32x2c_t v = {lo, hi}; bf16x2c_t b = __builtin_convertvector(v, bf16x2c_t); return __builtin_bit_cast(unsigned, b); }
typedef float f32x2 __attribute__((ext_vector_type(2)));
template <int ACT  > struct EpiBf16 {
    static constexpr bool PERM = true, AFTER_DRAIN = false; static_assert(ACT == 0 || ACT == 1, "EpiBf16: ACT is 0 (none) or 1 (gelu_pk)");
    bf16_t* O; int ldc; const float* bias; int split_cols; size_t split_stride; float scale0;
    __device__ __forceinline__ void operator()(const f32x4 (&acc)[2][2][4][2], const Unit& u, int wr, int wc, int fr, int fq) const {
        const int row0 = u.pm * BM + wr * 64 + fr; int colt = u.pn * BM; bf16_t* base = O;
        float sc = 1.f; if (split_cols) { const int t = colt / split_cols; base += (size_t)t * split_stride; colt -= t * split_cols; if (t == 0) sc = scale0; }
        const int col0 = colt + wc * 32 + 8 * fq, bcol0 = u.pn * BM + wc * 32 + 8 * fq;
        f32x4 bv[2][2];
#pragma unroll
        for (int bj = 0; bj < 2; ++bj)
#pragma unroll
            for (int n = 0; n < 2; ++n) bv[bj][n] = bias ? *(const f32x4*)(bias + bcol0 + bj * HALF + 4 * n) : (f32x4){0.f, 0.f, 0.f, 0.f};
#pragma unroll
        for (int ai = 0; ai < 2; ++ai)
#pragma unroll
            for (int m = 0; m < 4; ++m) { bf16_t* rowp = base + (size_t)(row0 + ai * HALF + m * 16) * ldc + col0;
#pragma unroll
                for (int bj = 0; bj < 2; ++bj) { f32x4 v0 = acc[ai][bj][m][0] + bv[bj][0], v1 = acc[ai][bj][m][1] + bv[bj][1];
                    v0 = v0 * sc; v1 = v1 * sc; u32x4 w; w.x = cvt_pk_bf16(v0[0], v0[1]); w.y = cvt_pk_bf16(v0[2], v0[3]); w.z = cvt_pk_bf16(v1[0], v1[1]); w.w = cvt_pk_bf16(v1[2], v1[3]);
                    *(u32x4*)(rowp + bj * HALF) = w; } }
    }
};
struct EpiRes {
    static constexpr bool PERM = false, AFTER_DRAIN = false;
    const float* base; float* out; const float* gate;
    __device__ __forceinline__ void operator()(const f32x4 (&acc)[2][2][4][2], const Unit& u, int wr, int wc, int fr, int fq) const {
        const int row0 = u.pm * BM + wr * 64 + fr, col0 = u.pn * BM + wc * 32 + 4 * fq;
        const float* gp = gate + (size_t)(u.pm >> 4) * 6144 + col0;
        f32x4 gv[2][2];
#pragma unroll
        for (int bj = 0; bj < 2; ++bj)
#pragma unroll
            for (int n = 0; n < 2; ++n) gv[bj][n] = *(const f32x4*)(gp + bj * HALF + n * 16);
#pragma unroll
        for (int ai = 0; ai < 2; ++ai)
#pragma unroll
            for (int m = 0; m < 4; ++m) { const size_t off = (size_t)(row0 + ai * HALF + m * 16) * 1024 + col0;
#pragma unroll
                for (int bj = 0; bj < 2; ++bj)
#pragma unroll
                    for (int n = 0; n < 2; ++n) { const f32x4 bs = *(const f32x4*)(base + off + bj * HALF + n * 16);
                        *(f32x4*)(out + off + bj * HALF + n * 16) = bs + gv[bj][n] * acc[ai][bj][m][n]; } }
    }
};
__device__ __forceinline__ float dpp_prev1(float prev, float cur) {
    const int t = __builtin_amdgcn_update_dpp(0, __float_as_int(prev), 0x121, 0xf, 0xf, false);
    return __int_as_float(__builtin_amdgcn_update_dpp(t, __float_as_int(cur), 0x111, 0xf, 0xf, false));
}
__device__ __forceinline__ float dpp_prev2(float prev, float cur) {
    const int t = __builtin_amdgcn_update_dpp(0, __float_as_int(prev), 0x122, 0xf, 0xf, false);
    return __int_as_float(__builtin_amdgcn_update_dpp(t, __float_as_int(cur), 0x112, 0xf, 0xf, false));
}
struct EpiConv {
    static constexpr bool PERM = true, AFTER_DRAIN = false;
    unsigned short* act; float* halo; const float* cw; const float* cb; PG8_LAS float* ex;
    __device__ __forceinline__ void operator()(const f32x4 (&acc)[2][2][4][2], const Unit& u, int wr, int wc, int fr, int fq) const {
        const int jj0 = wc * 32 + 8 * fq;
        if (fr >= 14) {
#pragma unroll
            for (int ai = 0; ai < 2; ++ai)
#pragma unroll
                for (int bj = 0; bj < 2; ++bj)
#pragma unroll
                    for (int n = 0; n < 2; ++n) *(PG8_LAS f32x4*)(ex + ((ai * 2 + wr) * 2 + (fr - 14)) * 256 + bj * 128 + jj0 + 4 * n) = acc[ai][bj][3][n];
        }
        float* hb = halo + (size_t)u.pm * 4 * 5632 + u.pn * 128 + jj0;
        if (wr == 0 && fr < 2) {
#pragma unroll
            for (int bj = 0; bj < 2; ++bj)
#pragma unroll
                for (int n = 0; n < 2; ++n) *(f32x4*)(hb + fr * 5632 + bj * 2816 + 4 * n) = acc[0][bj][0][n];
        }
        if (wr == 1 && fr >= 14) {
#pragma unroll
            for (int bj = 0; bj < 2; ++bj)
#pragma unroll
                for (int n = 0; n < 2; ++n) *(f32x4*)(hb + (fr - 12) * 5632 + bj * 2816 + 4 * n) = acc[1][bj][3][n];
        }
        asm volatile("s_waitcnt lgkmcnt(0)" ::: "memory"); __builtin_amdgcn_s_barrier(); asm volatile("" ::: "memory");
#pragma unroll
        for (int n = 0; n < 2; ++n) {
            const int vc = u.pn * 128 + jj0 + 4 * n;
            const f32x4 w0v = *(const f32x4*)(cw + vc), w1v = *(const f32x4*)(cw + 5632 + vc), w2v = *(const f32x4*)(cw + 11264 + vc), cbv = *(const f32x4*)(cb + vc);
            const f32x4 w0g = *(const f32x4*)(cw + 2816 + vc), w1g = *(const f32x4*)(cw + 5632 + 2816 + vc), w2g = *(const f32x4*)(cw + 11264 + 2816 + vc), cbg = *(const f32x4*)(cb + 2816 + vc);
#pragma unroll
            for (int ai = 0; ai < 2; ++ai) {
                f32x4 pv = (f32x4){0.f, 0.f, 0.f, 0.f}, pg = pv;
                const int pslot = ai * 2 + wr - 1;
                if (pslot >= 0) { pv = *(const PG8_LAS f32x4*)(ex + (pslot * 2 + (fr & 1)) * 256 + jj0 + 4 * n); pg = *(const PG8_LAS f32x4*)(ex + (pslot * 2 + (fr & 1)) * 256 + 128 + jj0 + 4 * n); }
#pragma unroll
                for (int m = 0; m < 4; ++m) {
                    const f32x4 cv = acc[ai][0][m][n], cg = acc[ai][1][m][n]; float o[4];
#pragma unroll
                    for (int i = 0; i < 4; ++i) {
                        const float v1 = dpp_prev1(pv[i], cv[i]), v2 = dpp_prev2(pv[i], cv[i]), g1 = dpp_prev1(pg[i], cg[i]), g2 = dpp_prev2(pg[i], cg[i]);
                        const float val = cbv[i] + w2v[i] * cv[i] + w1v[i] * v1 + w0v[i] * v2;
                        const float gat = cbg[i] + w2g[i] * cg[i] + w1g[i] * g1 + w0g[i] * g2;
                        o[i] = val * gat * __builtin_amdgcn_rcpf(1.0f + __builtin_amdgcn_exp2f(-1.4426950408889634f * gat));
                    }
                    typedef unsigned u32x2v __attribute__((ext_vector_type(2)));
                    u32x2v w; w.x = cvt_pk_bf16(o[0], o[1]); w.y = cvt_pk_bf16(o[2], o[3]);
                    *(u32x2v*)(act + (size_t)(u.pm * BM + ai * HALF + wr * 64 + m * 16 + fr) * 2816 + vc) = w;
                    pv = cv; pg = cg;
                }
            }
        }
    }
};
struct EpiInStat {
    static constexpr bool PERM = true, AFTER_DRAIN = false;
    bf16_t* O; int ldc; float* statq; float* statkv;
    __device__ __forceinline__ void operator()(const f32x4 (&acc)[2][2][4][2], const Unit& u, int wr, int wc, int fr, int fq) const {
        const int row0 = u.pm * BM + wr * 64 + fr, col0 = u.pn * BM + wc * 32 + 8 * fq;
        float one = 1.0f; asm volatile("" : "+v"(one));
#pragma unroll
        for (int ai = 0; ai < 2; ++ai)
#pragma unroll
            for (int m = 0; m < 4; ++m) { const int row = row0 + ai * HALF + m * 16; bf16_t* rowp = O + (size_t)row * ldc + col0; float s[2];
#pragma unroll
                for (int bj = 0; bj < 2; ++bj) { const f32x4 v0 = acc[ai][bj][m][0] * one, v1 = acc[ai][bj][m][1] * one;
                    u32x4 w; w.x = cvt_pk_bf16(v0[0], v0[1]); w.y = cvt_pk_bf16(v0[2], v0[3]); w.z = cvt_pk_bf16(v1[0], v1[1]); w.w = cvt_pk_bf16(v1[2], v1[3]);
                    *(u32x4*)(rowp + bj * HALF) = w;
                    float q = 0.f;
#pragma unroll
                    for (int j = 0; j < 4; ++j) { const float lo = __builtin_bit_cast(float, w[j] << 16), hh = __builtin_bit_cast(float, w[j] & 0xffff0000u); q += lo * lo + hh * hh; }
                    s[bj] = q; }
                if (u.pn <= 1) { float t = (u.pn == 0) ? s[0] + s[1] : s[0]; t += __shfl_xor(t, 16); t += __shfl_xor(t, 32);
                    if (fq == 0) { float* sp = (u.pn == 0) ? statq : statkv; sp[(size_t)row * 4 + wc] = t; } } }
    }
};
struct EpiRow {
    static constexpr bool PERM = true, AFTER_DRAIN = false;
    bf16_t* O; int ldc; const float* stat; float invk;
    __device__ __forceinline__ void operator()(const f32x4 (&acc)[2][2][4][2], const Unit& u, int wr, int wc, int fr, int fq) const {
        const int row0 = u.pm * BM + wr * 64 + fr, col0 = u.pn * BM + wc * 32 + 8 * fq;
#pragma unroll
        for (int ai = 0; ai < 2; ++ai)
#pragma unroll
            for (int m = 0; m < 4; ++m) { const int row = row0 + ai * HALF + m * 16; const f32x4 st = *(const f32x4*)(stat + (size_t)row * 4);
                const float rstd = rsqrtf(((st.x + st.y) + (st.z + st.w)) * invk + 1e-6f); bf16_t* rowp = O + (size_t)row * ldc + col0;
#pragma unroll
                for (int bj = 0; bj < 2; ++bj) { const f32x4 v0 = acc[ai][bj][m][0] * rstd, v1 = acc[ai][bj][m][1] * rstd;
                    u32x4 w; w.x = cvt_pk_bf16(v0[0], v0[1]); w.y = cvt_pk_bf16(v0[2], v0[3]); w.z = cvt_pk_bf16(v1[0], v1[1]); w.w = cvt_pk_bf16(v1[2], v1[3]);
                    *(u32x4*)(rowp + bj * HALF) = w; } }
    }
};
struct EpiQ {
    static constexpr bool PERM = false, AFTER_DRAIN = false;
    bf16_t* Q; const float* stat; const float* rc; const float* rs; float qscale;
    __device__ __forceinline__ void operator()(const f32x4 (&acc)[2][2][4][2], const Unit& u, int wr, int wc, int fr, int fq) const {
        typedef unsigned u32x2v __attribute__((ext_vector_type(2)));
        asm volatile("" : "+v"(fr), "+v"(fq));
        const int row0 = u.pm * BM + wr * 64 + fr;
#pragma unroll
        for (int ai = 0; ai < 2; ++ai)
#pragma unroll
            for (int m = 0; m < 4; ++m) { const int row = row0 + ai * HALF + m * 16; const f32x4 st = *(const f32x4*)(stat + (size_t)row * 4);
                const float rstd = rsqrtf(((st.x + st.y) + (st.z + st.w)) * (1.0f / 256.0f) + 1e-6f) * qscale;
#pragma unroll
                for (int bj = 0; bj < 2; ++bj) { const int gb = 8 * u.pn + 4 * bj + wc; f32x4 v0 = acc[ai][bj][m][0] * rstd, v1 = acc[ai][bj][m][1] * rstd;
                    if (gb % 3 == 2) { const f32x4 cc = *(const f32x4*)(rc + (size_t)row * 16 + 4 * fq), ss = *(const f32x4*)(rs + (size_t)row * 16 + 4 * fq);
                        const f32x4 t1 = v0, t2 = v1; v0 = t1 * cc - t2 * ss; v1 = t1 * ss + t2 * cc; }
                    bf16_t* qp = Q + (size_t)row * 768 + 32 * gb + 4 * fq;
                    u32x2v w0, w1; w0.x = cvt_pk_bf16(v0[0], v0[1]); w0.y = cvt_pk_bf16(v0[2], v0[3]); w1.x = cvt_pk_bf16(v1[0], v1[1]); w1.y = cvt_pk_bf16(v1[2], v1[3]);
                    *(u32x2v*)qp = w0; *(u32x2v*)(qp + 16) = w1; }
                asm volatile("" ::: "memory"); }
    }
};
struct EpiResNorm {
    static constexpr bool PERM = false, AFTER_DRAIN = true;
    const float* base; float* xout; const float* gate; const float* g; const float* sc; const float* sh; bf16_t* xn; float* fout; float* xbuf; unsigned* cnt;
    __device__ __forceinline__ void fused(f32x4 (&acc)[2][2][4][2], const Unit& u, int wr, int wc, int fr, int fq, PG8_LAS unsigned char* lds, int wid, int lane) const {
        PG8_LAS float* P = (PG8_LAS float*)lds;
        PG8_LAS float* S = (PG8_LAS float*)(lds + 4096);
        const int col0 = u.pn * BM + wc * 32 + 4 * fq, bidx = u.pm >> 4;
        const float* gp = gate + (size_t)bidx * 6144 + col0;
        f32x4 gv[2][2];
#pragma unroll
        for (int bj = 0; bj < 2; ++bj)
#pragma unroll
            for (int n = 0; n < 2; ++n) gv[bj][n] = *(const f32x4*)(gp + bj * HALF + n * 16);
#pragma unroll
        for (int ai = 0; ai < 2; ++ai)
#pragma unroll
            for (int m = 0; m < 4; ++m) { const int r = ai * HALF + wr * 64 + m * 16 + fr; const size_t off = (size_t)(u.pm * BM + r) * 1024 + col0; float s = 0.f;
#pragma unroll
                for (int bj = 0; bj < 2; ++bj)
#pragma unroll
                    for (int n = 0; n < 2; ++n) { const f32x4 bs = __builtin_nontemporal_load((const f32x4*)(base + off + bj * HALF + n * 16)); const f32x4 x = bs + gv[bj][n] * acc[ai][bj][m][n];
                        acc[ai][bj][m][n] = x; if (xout) *(f32x4*)(xout + off + bj * HALF + n * 16) = x; s += (x[0] * x[0] + x[1] * x[1]) + (x[2] * x[2] + x[3] * x[3]); }
                s += __shfl_xor(s, 16); s += __shfl_xor(s, 32);
                if (fq == 0) P[r * 4 + wc] = s;
                asm volatile("" : "+v"(acc[ai][0][m][0]), "+v"(acc[ai][0][m][1]), "+v"(acc[ai][1][m][0]), "+v"(acc[ai][1][m][1]));
                if (m & 1) asm volatile("" ::: "memory"); }
        asm volatile("s_waitcnt lgkmcnt(0)" ::: "memory"); __builtin_amdgcn_s_barrier(); asm volatile("" ::: "memory");
        const int row = wid * 32 + (lane & 31);
        if (lane < 32) { const f32x4 p4 = *(const PG8_LAS f32x4*)(P + row * 4);
            __hip_atomic_store(xbuf + ((size_t)(u.pm * BM + row) * 4 + u.pn), (p4.x + p4.y) + (p4.z + p4.w), __ATOMIC_RELAXED, __HIP_MEMORY_SCOPE_AGENT); }
        asm volatile("s_waitcnt vmcnt(0)" ::: "memory");
        if (lane == 0) __hip_atomic_fetch_add(cnt + 64 * u.pm, 1u, __ATOMIC_RELAXED, __HIP_MEMORY_SCOPE_AGENT);
        if (wid == 0) {
            unsigned spins = 0;
            while ((unsigned)__builtin_amdgcn_readfirstlane(__hip_atomic_load(cnt + 64 * u.pm, __ATOMIC_RELAXED, __HIP_MEMORY_SCOPE_AGENT)) < 32u) { __builtin_amdgcn_s_sleep(2); if (++spins > (1u << 22)) break; }
            __builtin_amdgcn_fence(__ATOMIC_ACQUIRE, "agent");
        }
        asm volatile("s_waitcnt vmcnt(0) lgkmcnt(0)" ::: "memory"); __builtin_amdgcn_s_barrier(); asm volatile("" ::: "memory");
        if (lane < 32) { const float* slot = xbuf + (size_t)(u.pm * BM + row) * 4; float t = 0.f;
#pragma unroll
            for (int k = 0; k < 4; ++k) t += __hip_atomic_load(slot + k, __ATOMIC_RELAXED, __HIP_MEMORY_SCOPE_AGENT);
            S[row] = rsqrtf(t * (1.0f / 1024.0f) + 1e-6f); }
        asm volatile("s_waitcnt lgkmcnt(0)" ::: "memory"); __builtin_amdgcn_s_barrier(); asm volatile("" ::: "memory");
        typedef unsigned u32x2v __attribute__((ext_vector_type(2)));
#pragma unroll
        for (int bj = 0; bj < 2; ++bj)
#pragma unroll
            for (int n = 0; n < 2; ++n) { const int c = col0 + bj * HALF + n * 16; const f32x4 gg = *(const f32x4*)(g + c);
                f32x4 mul = gg, add = (f32x4){0.f, 0.f, 0.f, 0.f};
                if (xn) { mul = gg * (*(const f32x4*)(sc + (size_t)bidx * 6144 + c) + 1.0f); add = *(const f32x4*)(sh + (size_t)bidx * 6144 + c); }
#pragma unroll
                for (int ai = 0; ai < 2; ++ai)
#pragma unroll
                    for (int m = 0; m < 4; ++m) { const int r = ai * HALF + wr * 64 + m * 16 + fr; const float rstd = S[r]; const size_t off = (size_t)(u.pm * BM + r) * 1024 + c;
                        const f32x4 y = acc[ai][bj][m][n] * rstd * mul + add;
                        if (xn) { u32x2v w; w.x = cvt_pk_bf16(y[0], y[1]); w.y = cvt_pk_bf16(y[2], y[3]); *(u32x2v*)(xn + off) = w; }
                        else *(f32x4*)(fout + off) = y; } }
    }
};
template <class Epi, class Sched, bool ALIGN_EPI = false, bool SP2 = false>
__device__ __forceinline__ void gemm_phase(PG8_LAS unsigned char* lds, const Gemm g, const Sched& S, const Epi& E) {
    const int tid = ltid(), wid = __builtin_amdgcn_readfirstlane(tid >> 6), lane = tid & 63, wr = wid >> 2, wc = wid & 3, fr = lane & 15, fq = lane >> 4;
    const int K = g.K, nt = K / BK, lda = g.lda;
    unsigned voffA[2], voffB[2];
#pragma unroll
    for (int i = 0; i < 2; ++i) { int R, C; stage_rc(tid * 16 + i * 8192, R, C); const int Rb = Epi::PERM ? ((R & ~31) + perm32(R & 31)) : R;
        voffA[i] = (unsigned)(R * lda + C) * 2u; voffB[i] = (unsigned)(Rb * K + C) * 2u; }
    const size_t kstep = (size_t)(BK * 2);
    const size_t hstepA = (size_t)HALF * lda * 2, tstepA = 2 * hstepA;
    const size_t hstep = (size_t)HALF * K * 2;
    const size_t tstep = 2 * hstep;
    const unsigned ldsw = (unsigned)wid * 1024u;
    const int aoff = lds_byte(wr * 64 + fr, fq * 8), boff = lds_byte(wc * 32 + fr, fq * 8);
#define PG8_SA(b, h) (((b) * 2 + (h)) * HTB)
#define PG8_SB(b, h) ((4 + (b) * 2 + (h)) * HTB)
#define PG8_STAGE(bufoff, gbase, voff) do { _Pragma("unroll") for (int _i = 0; _i < 2; ++_i) \
        __builtin_amdgcn_global_load_lds((const unsigned*)((const char*)(gbase) + (voff)[_i]), (PG8_LAS unsigned*)(lds + (bufoff) + ldsw + _i * 8192), 16, 0, 0); } while (0)
#define PG8_LDA(dst, b, h) do { _Pragma("unroll") for (int m = 0; m < 4; ++m) _Pragma("unroll") for (int k = 0; k < 2; ++k) dst[m][k] = *(const PG8_LAS bf16x8*)(lds + PG8_SA(b, h) + aoff + m * 2048 + k * 1024); } while (0)
#define PG8_LDB(dst, b, h) do { _Pragma("unroll") for (int n = 0; n < 2; ++n) _Pragma("unroll") for (int k = 0; k < 2; ++k) dst[n][k] = *(const PG8_LAS bf16x8*)(lds + PG8_SB(b, h) + boff + n * 2048 + k * 1024); } while (0)
#define PG8_MMA(ai, bj, At, Bt) do { __builtin_amdgcn_s_setprio(1); _Pragma("unroll") for (int m = 0; m < 4; ++m) _Pragma("unroll") for (int n = 0; n < 2; ++n) _Pragma("unroll") for (int k = 0; k < 2; ++k) \
        acc[ai][bj][m][n] = __builtin_amdgcn_mfma_f32_16x16x32_bf16(Bt[n][k], At[m][k], acc[ai][bj][m][n], 0, 0, 0); __builtin_amdgcn_s_setprio(0); } while (0)
#define PG8_WAIT_V(n) asm volatile("s_waitcnt vmcnt(" #n ")" ::: "memory")
#define PG8_WAIT_L(n) asm volatile("s_waitcnt lgkmcnt(" #n ")" ::: "memory")
#define PG8_BAR __builtin_amdgcn_s_barrier()
#define PG8_SCHED __builtin_amdgcn_sched_barrier(0)
    Unit cur, nxt; int ui = 0;
    if (!S.next(0, cur)) return;
    f32x4 acc[2][2][4][2];
#pragma unroll
    for (int a = 0; a < 2; ++a)
#pragma unroll
        for (int b = 0; b < 2; ++b)
#pragma unroll
            for (int m = 0; m < 4; ++m)
#pragma unroll
                for (int n = 0; n < 2; ++n) acc[a][b][m][n] = (f32x4){0.f, 0.f, 0.f, 0.f};
    bf16x8 At[4][2], B0[2][2], B1[2][2];
    const char* cA = (const char*)g.A + (size_t)cur.pm * tstepA; const char* cB = (const char*)g.Bt + (size_t)cur.pn * tstep;
    S.a_ready(cur);
    if constexpr (SP2) {
        PG8_STAGE(PG8_SB(0, 0), cB, voffB); PG8_STAGE(PG8_SB(0, 1), cB + hstep, voffB); PG8_STAGE(PG8_SA(0, 0), cA, voffA); PG8_STAGE(PG8_SA(0, 1), cA + hstepA, voffA);
        if (wr == 1) PG8_BAR;
        PG8_WAIT_V(2); PG8_BAR;
        PG8_STAGE(PG8_SB(1, 0), cB + kstep, voffB); PG8_STAGE(PG8_SA(1, 0), cA + kstep, voffA); PG8_STAGE(PG8_SB(1, 1), cB + hstep + kstep, voffB);
        PG8_WAIT_V(6); PG8_BAR;
    } else {
        PG8_STAGE(PG8_SB(0, 0), cB, voffB); PG8_STAGE(PG8_SA(0, 0), cA, voffA); PG8_STAGE(PG8_SB(0, 1), cB + hstep, voffB); PG8_STAGE(PG8_SA(0, 1), cA + hstepA, voffA);
        if (wr == 1) PG8_BAR;
        PG8_WAIT_V(4); PG8_BAR;
        PG8_STAGE(PG8_SB(1, 0), cB + kstep, voffB); PG8_STAGE(PG8_SA(1, 0), cA + kstep, voffA); PG8_STAGE(PG8_SB(1, 1), cB + hstep + kstep, voffB);
        PG8_WAIT_V(6); PG8_BAR;
    }
    for (;;) {
        const bool has_next = S.next(ui + 1, nxt);
        const char* nA = has_next ? (const char*)g.A + (size_t)nxt.pm * tstepA : cA; const char* nB = has_next ? (const char*)g.Bt + (size_t)nxt.pn * tstep : cB;
        for (int t = 0; t < nt; t += 2) {
            const bool last = (t == nt - 2);
            const char* a1 = cA + (size_t)(t + 1) * kstep;
            const char* a2 = last ? nA : cA + (size_t)(t + 2) * kstep; const char* b2 = last ? nB : cB + (size_t)(t + 2) * kstep;
            const char* a3 = a2 + kstep; const char* b3 = b2 + kstep;
            if (last && has_next) S.a_ready(nxt);
            if constexpr (SP2) {
            PG8_LDB(B0, 0, 0); PG8_LDB(B1, 0, 1); PG8_SCHED; PG8_LDA(At, 0, 0); PG8_STAGE(PG8_SA(1, 1), a1 + hstepA, voffA);
            PG8_WAIT_V(8); PG8_WAIT_L(0); PG8_BAR; PG8_MMA(0, 0, At, B0); PG8_MMA(0, 1, At, B1); PG8_BAR; PG8_SCHED;
            PG8_LDA(At, 0, 1); PG8_STAGE(PG8_SB(0, 0), b2, voffB); PG8_STAGE(PG8_SB(0, 1), b2 + hstep, voffB); PG8_STAGE(PG8_SA(0, 0), a2, voffA);
            PG8_WAIT_V(8); PG8_WAIT_L(0); PG8_BAR; PG8_MMA(1, 0, At, B0); PG8_MMA(1, 1, At, B1); PG8_BAR; PG8_SCHED;
            PG8_LDB(B0, 1, 0); PG8_LDB(B1, 1, 1); PG8_SCHED; PG8_LDA(At, 1, 0); PG8_STAGE(PG8_SA(0, 1), a2 + hstepA, voffA);
            PG8_WAIT_V(8); PG8_WAIT_L(0); PG8_BAR; PG8_MMA(0, 0, At, B0); PG8_MMA(0, 1, At, B1); PG8_BAR; PG8_SCHED;
            PG8_LDA(At, 1, 1); PG8_STAGE(PG8_SB(1, 0), b3, voffB); PG8_STAGE(PG8_SB(1, 1), b3 + hstep, voffB); PG8_STAGE(PG8_SA(1, 0), a3, voffA);
            PG8_WAIT_V(8); PG8_WAIT_L(0); PG8_BAR; PG8_MMA(1, 0, At, B0); PG8_MMA(1, 1, At, B1); PG8_BAR; PG8_SCHED;
            } else {
            PG8_LDB(B0, 0, 0); PG8_SCHED; PG8_LDA(At, 0, 0); PG8_STAGE(PG8_SA(1, 1), a1 + hstepA, voffA);
            PG8_WAIT_L(8); PG8_BAR; PG8_WAIT_L(0); PG8_MMA(0, 0, At, B0); PG8_BAR; PG8_SCHED;
            PG8_LDB(B1, 0, 1); PG8_STAGE(PG8_SB(0, 0), b2, voffB);
            PG8_BAR; PG8_WAIT_L(0); PG8_MMA(0, 1, At, B1); PG8_BAR;
            PG8_LDA(At, 0, 1); PG8_STAGE(PG8_SA(0, 0), a2, voffA);
            PG8_BAR; PG8_WAIT_L(0); PG8_MMA(1, 0, At, B0); PG8_BAR; PG8_SCHED;
            PG8_STAGE(PG8_SB(0, 1), b2 + hstep, voffB);
            PG8_WAIT_V(6); PG8_BAR; PG8_MMA(1, 1, At, B1); PG8_BAR;
            PG8_LDB(B0, 1, 0); PG8_SCHED; PG8_LDA(At, 1, 0); PG8_STAGE(PG8_SA(0, 1), a2 + hstepA, voffA);
            PG8_WAIT_L(8); PG8_BAR; PG8_WAIT_L(0); PG8_MMA(0, 0, At, B0); PG8_BAR; PG8_SCHED;
            PG8_LDB(B1, 1, 1); PG8_STAGE(PG8_SB(1, 0), b3, voffB);
            PG8_BAR; PG8_WAIT_L(0); PG8_MMA(0, 1, At, B1); PG8_BAR;
            PG8_LDA(At, 1, 1); PG8_STAGE(PG8_SA(1, 0), a3, voffA);
            PG8_BAR; PG8_WAIT_L(0); PG8_MMA(1, 0, At, B0); PG8_BAR; PG8_SCHED;
            PG8_STAGE(PG8_SB(1, 1), b3 + hstep, voffB);
            PG8_WAIT_V(6); PG8_BAR; PG8_MMA(1, 1, At, B1); PG8_BAR;
            }
        }
        if constexpr (ALIGN_EPI) { if (wr == 0) PG8_BAR; }
        if constexpr (!Epi::AFTER_DRAIN) { E(acc, cur, wr, wc, fr, fq); S.done(cur); }
        if (!has_next) break;
#pragma unroll
        for (int a = 0; a < 2; ++a)
#pragma unroll
            for (int b = 0; b < 2; ++b)
#pragma unroll
                for (int m = 0; m < 4; ++m)
#pragma unroll
                    for (int n = 0; n < 2; ++n) acc[a][b][m][n] = (f32x4){0.f, 0.f, 0.f, 0.f};
        cur = nxt; cA = nA; cB = nB; ++ui;
        if constexpr (ALIGN_EPI) { if (wr == 1) PG8_BAR; }
    }
    PG8_WAIT_V(0);
    if constexpr (!ALIGN_EPI) { if (wr == 0) PG8_BAR; }
    PG8_BAR;
    if constexpr (Epi::AFTER_DRAIN) { E.fused(acc, cur, wr, wc, fr, fq, lds, wid, lane); S.done(cur); }
#undef PG8_SA
#undef PG8_SB
#undef PG8_STAGE
#undef PG8_LDA
#undef PG8_LDB
#undef PG8_MMA
#undef PG8_WAIT_V
#undef PG8_WAIT_L
#undef PG8_BAR
#undef PG8_SCHED
}
}
#define LAS __attribute__((address_space(3)))
typedef unsigned short bf16;
typedef unsigned v4u __attribute__((ext_vector_type(4)));
typedef unsigned v2u __attribute__((ext_vector_type(2)));
typedef float f32x4 __attribute__((ext_vector_type(4)));
typedef float f32x16 __attribute__((ext_vector_type(16)));
typedef short bf16x8 __attribute__((ext_vector_type(8)));
typedef short s16x4 __attribute__((ext_vector_type(4)));
#define MFMA32(a, b, c) __builtin_amdgcn_mfma_f32_32x32x16_bf16((a), (b), (c), 0, 0, 0)
#define LDS_WAIT() asm volatile("s_waitcnt lgkmcnt(0)" ::: "memory")

constexpr int NWAVES = 8, NTHR = 512;
constexpr int M = 16384, D = 1024, SEQ = 4096, NBATCH = 4, DEPTH = 4;
constexpr int ZP = 1792;
constexpr int DFF = 2816;
constexpr float EPS = 1e-6f;
constexpr float QSCALE = 0.10206207261596575f * 1.4426950408889634f;
constexpr int ZC_CQ = 0, ZC_CKV = 256, ZC_KR = 384, ZC_SU = 416, ZC_SV = 672, ZC_GQ = 928, ZC_GK = 1056, ZC_GV = 1184, ZC_GLR = 1440, ZC_GR = 1456;
constexpr size_t MiB = 1u << 20;
constexpr size_t WS_MOD = 0, WS_HALO = 1 * MiB, WS_W = 8 * MiB, W_LAYER_BYTES = 23 * MiB;
constexpr size_t WS_XN = 100 * MiB, WS_Z = 132 * MiB, WS_Q = 188 * MiB, WS_KN = 212 * MiB, WS_VT = 228 * MiB, WS_KR = 244 * MiB, WS_ACT = 132 * MiB;
constexpr size_t WS_MIX = 246 * MiB, WS_OINTRA = 278 * MiB, WS_QT = 294 * MiB, WS_SLOC = 302 * MiB, WS_DEC = 310 * MiB;
constexpr size_t WS_KVB = 212 * MiB;
constexpr size_t WS_STATQ = 311 * MiB, WS_STATKV = 312 * MiB, WS_ROPEC = 313 * MiB, WS_ROPES = 314 * MiB, WS_END = 315 * MiB;
constexpr size_t WO_IN = 0, WO_UQ = 1835008, WO_UKV = 2031616, WO_OUT = 2162688, WO_UP = 3211264, WO_DN = 8978432;
constexpr int LDS_BYTES = 147456, EX_OFF = 131072, MISC_OFF = EX_OFF + 8192;
constexpr size_t WS_BAR = 7 * MiB;

struct Args {
    const float *x, *c; const int* pos;
    const float *mod_w, *mod_b, *norm_mix_g, *norm_ffn_g, *w_in, *q_norm_g, *kv_norm_g, *w_uq, *w_ukv, *sg_ln_g, *sg_ln_b, *sg_w_s, *sg_b_s, *gla_w2, *gla_bg, *gla_ng,
                *w_out, *w_up, *conv_w, *conv_b, *w_down, *final_g;
    float* out; unsigned char* ws; int ph_lo, ph_hi;
};

__device__ __forceinline__ unsigned f2bf(float f) { unsigned u = __builtin_bit_cast(unsigned, f); return (u + 0x7fffu + ((u >> 16) & 1u)) >> 16; }
__device__ __forceinline__ unsigned pk2(float lo, float hi) { return pg8::cvt_pk_bf16(lo, hi); }
__device__ __forceinline__ unsigned pk2s(float lo, float hi) { return pg8::cvt_pk_bf16_safe(lo, hi); }
__device__ __forceinline__ float bf2f(unsigned short h) { return __builtin_bit_cast(float, (unsigned)h << 16); }
__device__ __forceinline__ float bflo(unsigned w) { return __builtin_bit_cast(float, w << 16); }
__device__ __forceinline__ float bfhi(unsigned w) { return __builtin_bit_cast(float, w & 0xffff0000u); }
__device__ __forceinline__ int crow(int r, int hi) { return (r & 3) + 8 * (r >> 2) + 4 * hi; }
__device__ __forceinline__ float wave_sum(float v) {
#pragma unroll
    for (int o = 1; o < 64; o <<= 1) v += __shfl_xor(v, o);
    return v;
}
__device__ __forceinline__ float gelu_tanh(float x) {
    const float y = 0.7978845608028654f * (x + 0.044715f * x * x * x);
    const float e = __builtin_amdgcn_exp2f(2.8853900817779268f * y);
    return x * (1.0f - __builtin_amdgcn_rcpf(e + 1.0f));
}
__device__ __forceinline__ float silu_f(float x) { return x / (1.0f + __expf(-x)); }

__device__ __forceinline__ void transpose_item(const float* W, int K, int N, bf16* WT, int item, int nblk, int mode, const float* gk, LAS float* scr, int lane) {
    const int kb = item / nblk, nb = item % nblk, k0 = 64 * kb, n0 = 32 * nb;
    float tv[32];
#pragma unroll
    for (int i = 0; i < 32; ++i) { const int kk = 2 * i + (lane >> 5); const int n = n0 + (lane & 31); tv[i] = (n < N) ? W[(size_t)(k0 + kk) * N + n] : 0.f; }
#pragma unroll
    for (int i = 0; i < 32; ++i) { const int kk = 2 * i + (lane >> 5); float v = tv[i]; if (gk) v *= gk[k0 + kk]; scr[kk * 33 + (lane & 31)] = v; }
    LDS_WAIT();
    const int c = lane & 7;
    int rbase = n0;
    if (mode == 1) { if (n0 < DFF) rbase = 256 * (n0 / 128) + (n0 % 128); else { const int n1 = n0 - DFF; rbase = 256 * (n1 / 128) + 128 + (n1 % 128); } }
#pragma unroll
    for (int j = 0; j < 4; ++j) { const int n = (lane >> 3) + 8 * j; const LAS float* s = scr + (8 * c) * 33 + n;
        v4u o; o.x = pk2(s[0 * 33], s[1 * 33]); o.y = pk2(s[2 * 33], s[3 * 33]); o.z = pk2(s[4 * 33], s[5 * 33]); o.w = pk2(s[6 * 33], s[7 * 33]);
        *(v4u*)(WT + (size_t)(rbase + n) * K + k0 + 8 * c) = o; }
    LDS_WAIT();
}
__device__ __forceinline__ void phase_prologue(const Args& a, LAS unsigned char* lds) {
    const int tid = ltid(), lane = tid & 63, wave = tid >> 6, G = gridDim.x;
    LAS float* cact = (LAS float*)lds; LAS float* red = (LAS float*)(lds + 16384);
    for (int i = tid; i < 4096; i += NTHR) cact[i] = silu_f(a.c[i]);
    __syncthreads();
    float* MOD = (float*)(a.ws + WS_MOD);
    for (int it = blockIdx.x; it < 192; it += G) {
        const int l = it / 48, n0 = (it % 48) * 128, half = (tid >> 5) & 1, l32 = tid & 31;
        f32x4 acc[4];
#pragma unroll
        for (int b = 0; b < 4; ++b) acc[b] = (f32x4){0.f, 0.f, 0.f, 0.f};
        const float* wp = a.mod_w + (size_t)l * 1024 * 6144 + n0 + 4 * l32;
#pragma unroll 4
        for (int i = 0; i < 64; ++i) { const int k = wave * 128 + 2 * i + half; const f32x4 wv = *(const f32x4*)(wp + (size_t)k * 6144);
#pragma unroll
            for (int b = 0; b < 4; ++b) acc[b] += cact[b * 1024 + k] * wv; }
        const int pidx = wave * 2 + half;
#pragma unroll
        for (int b = 0; b < 4; ++b) *(LAS f32x4*)(red + (pidx * 4 + b) * 128 + 4 * l32) = acc[b];
        __syncthreads();
        { const int b = tid >> 7, col = tid & 127; float s = a.mod_b[l * 6144 + n0 + col];
#pragma unroll
            for (int p = 0; p < 16; ++p) s += red[(p * 4 + b) * 128 + col];
            MOD[(size_t)(l * 4 + b) * 6144 + n0 + col] = s; }
        __syncthreads();
    }
    __syncthreads();
    { float* RC = (float*)(a.ws + WS_ROPEC); float* RS = (float*)(a.ws + WS_ROPES);
      for (int e = blockIdx.x * NTHR + tid; e < M * 16; e += G * NTHR) { const int f = e & 15; const float inv = exp2f(-(float)f * (13.287712379549449f / 16.0f)); float s_, c_;
          sincosf((float)a.pos[e >> 4] * inv, &s_, &c_); RC[e] = c_; RS[e] = s_; } }
    LAS float* scr = (LAS float*)(lds + wave * 16384);
    const int gw = blockIdx.x * NWAVES + wave, NGW = G * NWAVES;
    constexpr int I_IN = 16 * 56, I_UQ = 4 * 24, I_UKV = 2 * 32, I_OUT = 16 * 32, I_UP = 16 * 176, I_DN = 44 * 32, I_L = I_IN + I_UQ + I_UKV + I_OUT + I_UP + I_DN;
    for (int it = gw; it < DEPTH * I_L; it += NGW) {
        const int l = it / I_L; int r = it % I_L;
        bf16* wl = (bf16*)(a.ws + WS_W + (size_t)l * W_LAYER_BYTES);
        if (r < I_IN) { transpose_item(a.w_in + (size_t)l * 1024 * 1712, 1024, 1712, wl + WO_IN, r, 56, 0, nullptr, scr, lane); continue; } r -= I_IN;
        if (r < I_UQ) { transpose_item(a.w_uq + (size_t)l * 256 * 768, 256, 768, wl + WO_UQ, r, 24, 0, a.q_norm_g + l * 256, scr, lane); continue; } r -= I_UQ;
        if (r < I_UKV) { transpose_item(a.w_ukv + (size_t)l * 128 * 1024, 128, 1024, wl + WO_UKV, r, 32, 0, a.kv_norm_g + l * 128, scr, lane); continue; } r -= I_UKV;
        if (r < I_OUT) { transpose_item(a.w_out + (size_t)l * 1024 * 1024, 1024, 1024, wl + WO_OUT, r, 32, 0, nullptr, scr, lane); continue; } r -= I_OUT;
        if (r < I_UP) { transpose_item(a.w_up + (size_t)l * 1024 * 5632, 1024, 5632, wl + WO_UP, r, 176, 1, nullptr, scr, lane); continue; } r -= I_UP;
        transpose_item(a.w_down + (size_t)l * 2816 * 1024, 2816, 1024, wl + WO_DN, r, 32, 0, nullptr, scr, lane);
    }
}

__device__ __forceinline__ void phase_norm(const float* x, const float* g, const float* modl, int sh_off, int sc_off, bf16* XN) {
    const int tid = ltid(), lane = tid & 63, wave = tid >> 6;
    const int gw = blockIdx.x * NWAVES + wave, NGW = gridDim.x * NWAVES;
    for (int m = gw; m < M; m += NGW) {
        const f32x4* xr = (const f32x4*)(x + (size_t)m * D) + lane;
        f32x4 v[4]; float s = 0.f;
#pragma unroll
        for (int j = 0; j < 4; ++j) { v[j] = xr[64 * j]; s += (v[j].x * v[j].x + v[j].y * v[j].y) + (v[j].z * v[j].z + v[j].w * v[j].w); }
        const float rstd = rsqrtf(wave_sum(s) * (1.f / D) + EPS);
        const float* mb = modl + (size_t)(m >> 12) * 6144;
#pragma unroll
        for (int j = 0; j < 4; ++j) { const int col = 4 * lane + 256 * j;
            const f32x4 gg = *(const f32x4*)(g + col), sc = *(const f32x4*)(mb + sc_off + col), sh = *(const f32x4*)(mb + sh_off + col);
            const f32x4 y = v[j] * rstd * gg * (sc + 1.0f) + sh;
            v2u o; o.x = pk2(y.x, y.y); o.y = pk2(y.z, y.w);
            *(v2u*)(XN + (size_t)m * D + col) = o; }
    }
}
__device__ __forceinline__ void phase_final_norm(float* x, const float* g) {
    const int tid = ltid(), lane = tid & 63, wave = tid >> 6;
    const int gw = blockIdx.x * NWAVES + wave, NGW = gridDim.x * NWAVES;
    for (int m = gw; m < M; m += NGW) {
        f32x4* xr = (f32x4*)(x + (size_t)m * D) + lane;
        f32x4 v[4]; float s = 0.f;
#pragma unroll
        for (int j = 0; j < 4; ++j) { v[j] = xr[64 * j]; s += (v[j].x * v[j].x + v[j].y * v[j].y) + (v[j].z * v[j].z + v[j].w * v[j].w); }
        const float rstd = rsqrtf(wave_sum(s) * (1.f / D) + EPS);
#pragma unroll
        for (int j = 0; j < 4; ++j) { const f32x4 gg = *(const f32x4*)(g + 4 * lane + 256 * j); xr[64 * j] = v[j] * rstd * gg; }
    }
}
__device__ __forceinline__ void p3_sgu(const Args& a, int l, int unit, LAS unsigned char* lds) {
    const int tid = ltid(), lane = tid & 63, wave = tid >> 6, hi = lane >> 5, m0 = (unit >> 1) * 128, hp = unit & 1;
    const bf16* Z = (const bf16*)(a.ws + WS_Z); bf16* MIX = (bf16*)(a.ws + WS_MIX);
    LAS bf16* vT = (LAS bf16*)lds;
    const int h = 2 * hp + (wave >> 2), j4 = wave & 3;
    const float* Wh = a.sg_w_s + ((size_t)(l * 4 + h)) * 128 * 128; const float* bs = a.sg_b_s + (l * 4 + h) * 128;
    { const int s = tid >> 2, qd = tid & 3; const bf16* zr = Z + (size_t)(m0 + s) * ZP + ZC_SV + 64 * qd;
      float v[64]; float sum = 0.f;
#pragma unroll
      for (int c8 = 0; c8 < 8; ++c8) { const v4u raw = *(const v4u*)(zr + 8 * c8);
#pragma unroll
          for (int j = 0; j < 4; ++j) { const float x0 = gelu_tanh(bflo(raw[j])), x1 = gelu_tanh(bfhi(raw[j])); v[8 * c8 + 2 * j] = x0; v[8 * c8 + 2 * j + 1] = x1; sum += x0 + x1; } }
      sum += __shfl_xor(sum, 1); sum += __shfl_xor(sum, 2);
      const float mean = sum * (1.0f / 256.0f); float q = 0.f;
#pragma unroll
      for (int c = 0; c < 64; ++c) { const float d_ = v[c] - mean; q += d_ * d_; }
      q += __shfl_xor(q, 1); q += __shfl_xor(q, 2);
      const float rstd = rsqrtf(q * (1.0f / 256.0f) + EPS);
      if ((qd >> 1) == hp) { const float* lg = a.sg_ln_g + l * 256 + 64 * qd; const float* lb = a.sg_ln_b + l * 256 + 64 * qd; LAS bf16* vq = vT + (64 * (qd & 1)) * 136 + s;
#pragma unroll
          for (int c = 0; c < 64; ++c) vq[c * 136] = (bf16)f2bf((v[c] - mean) * rstd * lg[c] + lb[c]); }
    }
    __syncthreads();
#pragma unroll
    for (int tl = 0; tl < 2; ++tl) {
        const int tb = tl ? 3 - j4 : j4, cl = 32 * tl + (lane & 31), ch = 64 * h + cl, t = 32 * tb + (lane & 31);
        f32x16 acc = {};
        bf16 su[16];
#pragma unroll
        for (int r = 0; r < 16; ++r) su[r] = Z[(size_t)(m0 + 32 * tb + crow(r, hi)) * ZP + ZC_SU + ch];
        float bsv[16];
#pragma unroll
        for (int g4 = 0; g4 < 4; ++g4) { const f32x4 b4 = *(const f32x4*)(bs + 32 * tb + 8 * g4 + 4 * hi); bsv[4 * g4] = b4.x; bsv[4 * g4 + 1] = b4.y; bsv[4 * g4 + 2] = b4.z; bsv[4 * g4 + 3] = b4.w; }
        f32x4 w0[8], w1[8];
#pragma unroll
        for (int ks = 0; ks < 8; ++ks) if (ks < 2 * (tb + 1)) { const int s0 = 16 * ks + 8 * hi; w0[ks] = *(const f32x4*)(Wh + t * 128 + s0); w1[ks] = *(const f32x4*)(Wh + t * 128 + s0 + 4); }
#pragma unroll
        for (int ks = 0; ks < 8; ++ks) if (ks < 2 * (tb + 1)) {
            const int s0 = 16 * ks + 8 * hi;
            v4u af; af.x = pk2s(s0 + 0 <= t ? w0[ks].x : 0.f, s0 + 1 <= t ? w0[ks].y : 0.f); af.y = pk2s(s0 + 2 <= t ? w0[ks].z : 0.f, s0 + 3 <= t ? w0[ks].w : 0.f);
            af.z = pk2s(s0 + 4 <= t ? w1[ks].x : 0.f, s0 + 5 <= t ? w1[ks].y : 0.f); af.w = pk2s(s0 + 6 <= t ? w1[ks].z : 0.f, s0 + 7 <= t ? w1[ks].w : 0.f);
            const bf16x8 bfr = *(const LAS bf16x8*)(vT + (64 * (wave >> 2) + cl) * 136 + s0);
            acc = MFMA32(__builtin_bit_cast(bf16x8, af), bfr, acc);
        }
#pragma unroll
        for (int r = 0; r < 16; ++r) { const int tt = 32 * tb + crow(r, hi); const size_t m = (size_t)(m0 + tt);
            const float u = gelu_tanh(bf2f(su[r])); MIX[m * 1024 + 512 + ch] = (bf16)f2bf(u * (acc[r] + bsv[r])); }
    }
    __syncthreads();
}
constexpr int GW_QS = 0, GW_KS = 5120, GW_KD = 10240, GW_VT = 14848, GW_BB = 24064, GW_BYTES = 24064 + 64 * 33 * 4;
__device__ __forceinline__ void p3_gla_stage1(const Args& a, int l, int unit, LAS unsigned char* wl, int lane, int half) {
    asm volatile("" : "+v"(lane));
    const int bh = unit >> 6, n = unit & 63, b = bh >> 2, h = bh & 3, m0 = b * SEQ + 64 * n, d0 = 16 * half;
    const bf16* Z = (const bf16*)(a.ws + WS_Z); const bf16* zr = Z + (size_t)(m0 + lane) * ZP;
    float* QT = (float*)(a.ws + WS_QT); float* DEC = (float*)(a.ws + WS_DEC);
    LAS bf16* Qs = (LAS bf16*)(wl + GW_QS); LAS bf16* Ks = (LAS bf16*)(wl + GW_KS); LAS bf16* KdT = (LAS bf16*)(wl + GW_KD); LAS bf16* Vt = (LAS bf16*)(wl + GW_VT);
    LAS float* bbL = (LAS float*)(wl + GW_BB) + lane * 33;
    v4u qraw[2], kraw[2];
#pragma unroll
    for (int c = 0; c < 2; ++c) { qraw[c] = *(const v4u*)(zr + ZC_GQ + h * 32 + d0 + 8 * c); kraw[c] = *(const v4u*)(zr + ZC_GK + h * 32 + d0 + 8 * c); }
    {
#pragma unroll
        for (int c8 = 0; c8 < 4; ++c8) { const int cc = 32 * half + 8 * c8; const v4u raw = *(const v4u*)(zr + ZC_GV + h * 64 + cc);
#pragma unroll
            for (int j = 0; j < 4; ++j) { Vt[(cc + 2 * j) * 72 + lane] = (bf16)(raw[j] & 0xffffu); Vt[(cc + 2 * j + 1) * 72 + lane] = (bf16)(raw[j] >> 16); } }
    }
    {
        float g[16];
        { const v4u r0 = *(const v4u*)(zr + ZC_GLR), r1 = *(const v4u*)(zr + ZC_GLR + 8);
#pragma unroll
          for (int j = 0; j < 4; ++j) { g[2 * j] = bflo(r0[j]); g[2 * j + 1] = bfhi(r0[j]); g[8 + 2 * j] = bflo(r1[j]); g[8 + 2 * j + 1] = bfhi(r1[j]); } }
        const float* w2 = a.gla_w2 + (size_t)l * 2048 + h * 32 + d0; const float* bg = a.gla_bg + l * 128 + h * 32 + d0;
#pragma unroll 4
        for (int d = 0; d < 16; ++d) { float x = bg[d];
#pragma unroll
            for (int r = 0; r < 16; ++r) x += g[r] * w2[r * 128 + d];
            bbL[d0 + d] = (fminf(x, 0.f) - __logf(1.0f + __expf(-fabsf(x)))) * (1.0f / 16.0f); }
    }
#pragma unroll 8
    for (int d = 0; d < 16; ++d) { float v = bbL[d0 + d];
#pragma unroll
        for (int off = 1; off < 64; off <<= 1) { const float t = __int_as_float(__builtin_amdgcn_ds_bpermute(((lane - off) & 63) << 2, __float_as_int(v))); if (lane >= off) v += t; }
        bbL[d0 + d] = v; }
    LDS_WAIT(); __builtin_amdgcn_wave_barrier();
    {
        const LAS float* blL = (const LAS float*)(wl + GW_BB) + 63 * 33;
        float* qtp = QT + (size_t)(m0 + lane) * 128 + h * 32 + d0;
#pragma unroll
        for (int c = 0; c < 2; ++c) { float qv[8], kt[8]; v4u qo, ko;
#pragma unroll
            for (int j = 0; j < 4; ++j) {
#pragma unroll
                for (int e = 0; e < 2; ++e) { const int d = d0 + 8 * c + 2 * j + e; const float q = e ? bfhi(qraw[c][j]) : bflo(qraw[c][j]), k = e ? bfhi(kraw[c][j]) : bflo(kraw[c][j]);
                    const float bv = bbL[d], bl = blL[d];
                    qv[2 * j + e] = q * 0.17677669529663687f * __expf(bv); kt[2 * j + e] = k * __expf(-bv);
                    KdT[d * 72 + lane] = (bf16)f2bf(k * __expf(bl - bv)); } }
#pragma unroll
            for (int j = 0; j < 4; ++j) { qo[j] = pk2s(qv[2 * j], qv[2 * j + 1]); ko[j] = pk2s(kt[2 * j], kt[2 * j + 1]); }
            *(LAS v4u*)(Qs + lane * 40 + d0 + 8 * c) = qo; *(LAS v4u*)(Ks + lane * 40 + d0 + 8 * c) = ko;
            *(f32x4*)(qtp + 8 * c) = (f32x4){qv[0], qv[1], qv[2], qv[3]}; *(f32x4*)(qtp + 8 * c + 4) = (f32x4){qv[4], qv[5], qv[6], qv[7]}; }
        if (lane < 16) DEC[(size_t)unit * 32 + d0 + lane] = __expf(blL[d0 + lane]);
    }
}
__device__ __forceinline__ void p3_gla_stage2(const Args& a, int unit, LAS unsigned char* wl, int lane, int half) {
    asm volatile("" : "+v"(lane));
    const int hi = lane >> 5, r32 = lane & 31;
    const int bh = unit >> 6, n = unit & 63, b = bh >> 2, h = bh & 3, m0 = b * SEQ + 64 * n;
    float* OI = (float*)(a.ws + WS_OINTRA); float* SL = (float*)(a.ws + WS_SLOC);
    LAS bf16* Qs = (LAS bf16*)(wl + GW_QS); LAS bf16* Ks = (LAS bf16*)(wl + GW_KS); LAS bf16* KdT = (LAS bf16*)(wl + GW_KD); LAS bf16* Vt = (LAS bf16*)(wl + GW_VT);
    if (half == 0) {
        f32x16 st00 = {}, st01 = {}, st11 = {};
#pragma unroll
        for (int ks = 0; ks < 2; ++ks) {
            const bf16x8 k0 = *(const LAS bf16x8*)(Ks + r32 * 40 + 16 * ks + 8 * hi), k1 = *(const LAS bf16x8*)(Ks + (32 + r32) * 40 + 16 * ks + 8 * hi);
            const bf16x8 q0 = *(const LAS bf16x8*)(Qs + r32 * 40 + 16 * ks + 8 * hi), q1 = *(const LAS bf16x8*)(Qs + (32 + r32) * 40 + 16 * ks + 8 * hi);
            st00 = MFMA32(k0, q0, st00); st01 = MFMA32(k0, q1, st01); st11 = MFMA32(k1, q1, st11);
        }
#pragma unroll
        for (int r = 0; r < 16; ++r) if (crow(r, hi) > r32) { st00[r] = 0.f; st11[r] = 0.f; }
        f32x16 o00 = {}, o01 = {}, o10 = {}, o11 = {};
#pragma unroll
        for (int kk = 0; kk < 2; ++kk) {
            v4u p00, p01, p11;
#pragma unroll
            for (int j = 0; j < 4; ++j) { const int r = 8 * kk + 2 * j; p00[j] = pk2s(st00[r], st00[r + 1]); p01[j] = pk2s(st01[r], st01[r + 1]); p11[j] = pk2s(st11[r], st11[r + 1]); }
#pragma unroll
            for (int cb = 0; cb < 2; ++cb) {
                const LAS bf16* vp = Vt + (32 * cb + r32) * 72 + 16 * kk + 4 * hi;
                const s16x4 a0 = *(const LAS s16x4*)(vp), a1 = *(const LAS s16x4*)(vp + 8), c0 = *(const LAS s16x4*)(vp + 32), c1 = *(const LAS s16x4*)(vp + 40);
                const bf16x8 vj0 = (bf16x8){a0[0], a0[1], a0[2], a0[3], a1[0], a1[1], a1[2], a1[3]}, vj1 = (bf16x8){c0[0], c0[1], c0[2], c0[3], c1[0], c1[1], c1[2], c1[3]};
                if (cb == 0) { o00 = MFMA32(__builtin_bit_cast(bf16x8, p00), vj0, o00); o10 = MFMA32(__builtin_bit_cast(bf16x8, p01), vj0, o10); o10 = MFMA32(__builtin_bit_cast(bf16x8, p11), vj1, o10); }
                else         { o01 = MFMA32(__builtin_bit_cast(bf16x8, p00), vj0, o01); o11 = MFMA32(__builtin_bit_cast(bf16x8, p01), vj0, o11); o11 = MFMA32(__builtin_bit_cast(bf16x8, p11), vj1, o11); }
            }
        }
        float* ob = OI + (size_t)(m0 + 4 * hi) * 256 + h * 64 + r32;
#pragma unroll
        for (int r = 0; r < 16; ++r) { float* op = ob + ((r & 3) + 8 * (r >> 2)) * 256;
            op[0] = o00[r]; op[32] = o01[r]; op[32 * 256] = o10[r]; op[32 * 256 + 32] = o11[r];
            if ((r & 3) == 3) asm volatile("" ::: "memory"); }
    } else {
        f32x16 s0 = {}, s1 = {};
#pragma unroll
        for (int ks = 0; ks < 4; ++ks) {
            const bf16x8 af = *(const LAS bf16x8*)(KdT + r32 * 72 + 16 * ks + 8 * hi);
            const bf16x8 b0 = *(const LAS bf16x8*)(Vt + r32 * 72 + 16 * ks + 8 * hi), b1 = *(const LAS bf16x8*)(Vt + (32 + r32) * 72 + 16 * ks + 8 * hi);
            s0 = MFMA32(af, b0, s0); s1 = MFMA32(af, b1, s1);
        }
        float* sb = SL + (size_t)unit * 2048 + 4 * hi * 64 + r32;
#pragma unroll
        for (int r = 0; r < 16; ++r) { float* sp = sb + ((r & 3) + 8 * (r >> 2)) * 64; sp[0] = s0[r]; sp[32] = s1[r]; if ((r & 3) == 3) asm volatile("" ::: "memory"); }
    }
}
#ifndef EXP_GLA_REP
#define EXP_GLA_REP 1
#endif
#ifndef EXP_SGU_REP
#define EXP_SGU_REP 1
#endif
__device__ __forceinline__ void phase_mid(const Args& a, int l, LAS unsigned char* lds) {
    const int G = gridDim.x;
    const bf16* wl = (const bf16*)(a.ws + WS_W + (size_t)l * W_LAYER_BYTES);
    const bf16* Z = (const bf16*)(a.ws + WS_Z);
    {
        pg8::Gemm g{Z + ZC_CQ, wl + WO_UQ, M, 768, 256, ZP}; pg8::StaticOrder S; S.init(M, 768, G, (int)blockIdx.x);
        pg8::EpiQ E{(bf16*)(a.ws + WS_Q), (const float*)(a.ws + WS_STATQ), (const float*)(a.ws + WS_ROPEC), (const float*)(a.ws + WS_ROPES), QSCALE};
        pg8::gemm_phase<pg8::EpiQ, pg8::StaticOrder, true, true>(lds, g, S, E);
    }
    {
        pg8::Gemm g{Z + ZC_CKV, wl + WO_UKV, M, 1024, 128, ZP}; pg8::StaticOrder S; S.init(M, 1024, G, (int)blockIdx.x);
        pg8::EpiRow E{(bf16*)(a.ws + WS_KVB), 1024, (const float*)(a.ws + WS_STATKV), 1.0f / 128.0f};
        pg8::gemm_phase<pg8::EpiRow, pg8::StaticOrder, true, true>(lds, g, S, E);
    }
    {
        const int tid = ltid(); bf16* KR = (bf16*)(a.ws + WS_KR); const float* RC = (const float*)(a.ws + WS_ROPEC); const float* RS = (const float*)(a.ws + WS_ROPES);
        for (int e = blockIdx.x * NTHR + tid; e < M * 16; e += G * NTHR) { const int m = e >> 4, f = e & 15;
            const float t1 = bf2f(Z[(size_t)m * ZP + ZC_KR + f]), t2 = bf2f(Z[(size_t)m * ZP + ZC_KR + 16 + f]), c_ = RC[e], s_ = RS[e];
            KR[(size_t)m * 32 + f] = (bf16)f2bf(t1 * c_ - t2 * s_); KR[(size_t)m * 32 + 16 + f] = (bf16)f2bf(t1 * s_ + t2 * c_); }
    }
    for (int rep = 0; rep < EXP_SGU_REP; ++rep)
    for (int u = blockIdx.x; u < 256; u += G) p3_sgu(a, l, u, lds);
    __syncthreads();
    { const int tid = ltid(), wave = __builtin_amdgcn_readfirstlane(tid >> 6), pr = wave >> 1, half = wave & 1;
      for (int rep = 0; rep < EXP_GLA_REP; ++rep) for (int u0 = blockIdx.x * 4; u0 < 1024; u0 += G * 4) {
          p3_gla_stage1(a, l, u0 + pr, lds + pr * GW_BYTES, tid & 63, half);
          __syncthreads();
          p3_gla_stage2(a, u0 + pr, lds + pr * GW_BYTES, tid & 63, half);
          __syncthreads(); } }
    __syncthreads();
}
constexpr int KS_PITCH = 104, VS_PITCH = 72, KS_BYTES = 64 * KS_PITCH * 2, VS_BYTES = 64 * VS_PITCH * 2, ABUF = KS_BYTES + VS_BYTES, WSF_OFF = 2 * ABUF;
__device__ __forceinline__ void attn_unit(const Args& a, int b, int h, int qb, LAS unsigned char* lds) {
    const int tid = ltid(), lane = tid & 63, wave = tid >> 6, hi = lane >> 5, r32 = lane & 31;
    const bf16* Q = (const bf16*)(a.ws + WS_Q); const bf16* KVB = (const bf16*)(a.ws + WS_KVB); const bf16* KR = (const bf16*)(a.ws + WS_KR);
    bf16* MIX = (bf16*)(a.ws + WS_MIX);
    const int rowbase = b * SEQ, q0 = qb * 256, qrow = q0 + 32 * wave + r32, NT = 4 * (qb + 1);
    LAS float* wsf = (LAS float*)(lds + WSF_OFF) + wave * 32;
    bf16x8 qf[6];
#pragma unroll
    for (int ks = 0; ks < 6; ++ks) qf[ks] = *(const bf16x8*)(Q + (size_t)(rowbase + qrow) * 768 + h * 96 + 16 * ks + 8 * hi);
    const bf16* ksrc = KVB + (size_t)(rowbase + (tid >> 3)) * 1024 + h * 128 + 8 * (tid & 7);
    const bf16* rsrc = KR + (size_t)(rowbase + ((tid & 255) >> 2)) * 32 + 8 * (tid & 3);
    const bf16* vsrc = KVB + (size_t)(rowbase + lane) * 1024 + h * 128 + 64 + 8 * wave;
    const int kdst = (tid >> 3) * KS_PITCH * 2 + 16 * (tid & 7), rdst = ((tid & 255) >> 2) * KS_PITCH * 2 + 128 + 16 * (tid & 3), vdst = KS_BYTES + (8 * wave) * VS_PITCH * 2 + 2 * ((lane & ~12) | ((lane & 4) << 1) | ((lane & 8) >> 1));
    v4u kreg, rreg, vreg;
#define VST(base, v) do { _Pragma("unroll") for (int j_ = 0; j_ < 4; ++j_) { *(LAS bf16*)((base) + vdst + (2 * j_) * VS_PITCH * 2) = (bf16)((v)[j_] & 0xffffu); *(LAS bf16*)((base) + vdst + (2 * j_ + 1) * VS_PITCH * 2) = (bf16)((v)[j_] >> 16); } } while (0)
    kreg = *(const v4u*)ksrc; if (tid < 256) rreg = *(const v4u*)rsrc; vreg = *(const v4u*)vsrc;
    *(LAS v4u*)(lds + kdst) = kreg; if (tid < 256) *(LAS v4u*)(lds + rdst) = rreg; VST(lds, vreg);
    __syncthreads();
    float m_run = -1e30f, l_run = 0.f; f32x16 o0 = {}, o1 = {};
    for (int t = 0; t < NT; ++t) {
        const bool more = (t + 1 < NT);
        if (more) { kreg = *(const v4u*)(ksrc + (size_t)(t + 1) * 64 * 1024); if (tid < 256) rreg = *(const v4u*)(rsrc + (size_t)(t + 1) * 64 * 32); vreg = *(const v4u*)(vsrc + (size_t)(t + 1) * 64 * 1024); }
        if (64 * t <= q0 + 32 * wave + 31) {
            LAS const unsigned char* kb = lds + (t & 1) * ABUF; LAS const unsigned char* vb = kb + KS_BYTES;
            f32x16 s0 = {}, s1 = {};
            bf16x8 kf0[6], kf1[6], vf0[4], vf1[4];
#pragma unroll
            for (int ks = 0; ks < 6; ++ks) { kf0[ks] = *(const LAS bf16x8*)(kb + r32 * KS_PITCH * 2 + 32 * ks + 16 * hi); kf1[ks] = *(const LAS bf16x8*)(kb + (32 + r32) * KS_PITCH * 2 + 32 * ks + 16 * hi); }
#pragma unroll
            for (int kk = 0; kk < 4; ++kk) { vf0[kk] = *(const LAS bf16x8*)(vb + r32 * VS_PITCH * 2 + 32 * kk + 16 * hi); vf1[kk] = *(const LAS bf16x8*)(vb + (32 + r32) * VS_PITCH * 2 + 32 * kk + 16 * hi); }
            __builtin_amdgcn_sched_barrier(0);
#pragma unroll
            for (int ks = 0; ks < 6; ++ks) { s0 = MFMA32(kf0[ks], qf[ks], s0); s1 = MFMA32(kf1[ks], qf[ks], s1); }
            if (64 * t + 63 > q0 + 32 * wave) {
#pragma unroll
                for (int r = 0; r < 16; ++r) { const int key = 64 * t + crow(r, hi); if (key > qrow) s0[r] = -1e30f; if (key + 32 > qrow) s1[r] = -1e30f; }
            }
            float mx = fmaxf(s0[0], s1[0]);
#pragma unroll
            for (int r = 1; r < 16; ++r) mx = fmaxf(mx, fmaxf(s0[r], s1[r]));
            { const auto rr_ = __builtin_amdgcn_permlane32_swap(__float_as_uint(mx), __float_as_uint(mx), false, false); mx = fmaxf(__uint_as_float(rr_[0]), __uint_as_float(rr_[1])); }
            const float m_new = (mx > m_run + 8.0f) ? mx : m_run;
            const float alpha = __builtin_amdgcn_exp2f(m_run - m_new);
            const bool resc = __any(m_new != m_run);
            m_run = m_new;
            float rs = 0.f;
#pragma unroll
            for (int r = 0; r < 16; ++r) { s0[r] = __builtin_amdgcn_exp2f(s0[r] - m_new); s1[r] = __builtin_amdgcn_exp2f(s1[r] - m_new); rs += s0[r] + s1[r]; }
            l_run = l_run * alpha + rs;
            if (resc) {
                if (hi == 0) wsf[r32] = alpha;
                LDS_WAIT();
#pragma unroll
                for (int g4 = 0; g4 < 4; ++g4) { const f32x4 al = *(const LAS f32x4*)(wsf + 8 * g4 + 4 * hi);
#pragma unroll
                    for (int i = 0; i < 4; ++i) { o0[4 * g4 + i] *= al[i]; o1[4 * g4 + i] *= al[i]; } }
                LDS_WAIT();
            }
            bf16x8 pa[4];
#pragma unroll
            for (int kk = 0; kk < 4; ++kk) { v4u p;
#pragma unroll
                for (int j = 0; j < 4; ++j) { const int r = 8 * (kk & 1) + 2 * j; p[j] = (kk < 2) ? pk2s(s0[r], s0[r + 1]) : pk2s(s1[r], s1[r + 1]); }
                pa[kk] = __builtin_bit_cast(bf16x8, p); }
#pragma unroll
            for (int kk = 0; kk < 4; ++kk) { o0 = MFMA32(pa[kk], vf0[kk], o0); o1 = MFMA32(pa[kk], vf1[kk], o1); }
        }
        if (more) { LAS unsigned char* nb = lds + ((t + 1) & 1) * ABUF; *(LAS v4u*)(nb + kdst) = kreg; if (tid < 256) *(LAS v4u*)(nb + rdst) = rreg; VST(nb, vreg); }
        __syncthreads();
    }
    l_run += __shfl_xor(l_run, 32);
    if (hi == 0) wsf[r32] = 1.0f / l_run;
    LDS_WAIT();
#pragma unroll
    for (int g4 = 0; g4 < 4; ++g4) { const f32x4 il = *(const LAS f32x4*)(wsf + 8 * g4 + 4 * hi);
#pragma unroll
        for (int i = 0; i < 4; ++i) { const int r = 4 * g4 + i; const size_t m = (size_t)(rowbase + q0 + 32 * wave + crow(r, hi));
            MIX[m * 1024 + h * 64 + r32] = (bf16)f2bf(o0[r] * il[i]); MIX[m * 1024 + h * 64 + 32 + r32] = (bf16)f2bf(o1[r] * il[i]); } }
    LDS_WAIT();
    __syncthreads();
#undef VST
}
__device__ __forceinline__ void gla_fin_unit(const Args& a, int l, int unit, const LAS float* Sn, int tid) {
    const bf16* Z = (const bf16*)(a.ws + WS_Z); bf16* MIX = (bf16*)(a.ws + WS_MIX);
    const float* OI = (const float*)(a.ws + WS_OINTRA); const float* QT = (const float*)(a.ws + WS_QT);
    const int bh = unit >> 6, n = unit & 63, b = bh >> 2, h = bh & 3, m0 = b * SEQ + 64 * n;
    const int i = tid >> 3, g8 = tid & 7; const size_t m = (size_t)(m0 + i);
    const float* op = OI + m * 256 + h * 64 + g8 * 8;
    f32x4 oa = *(const f32x4*)op, ob = *(const f32x4*)(op + 4);
    const float* qp = QT + m * 128 + h * 32;
#pragma unroll 2
    for (int d4 = 0; d4 < 8; ++d4) { const f32x4 qv = *(const f32x4*)(qp + 4 * d4);
#pragma unroll
        for (int dd = 0; dd < 4; ++dd) { const int d = 4 * d4 + dd; oa += qv[dd] * *(const LAS f32x4*)(Sn + d * 64 + g8 * 8); ob += qv[dd] * *(const LAS f32x4*)(Sn + d * 64 + g8 * 8 + 4); } }
    float ss = (oa.x * oa.x + oa.y * oa.y) + (oa.z * oa.z + oa.w * oa.w) + (ob.x * ob.x + ob.y * ob.y) + (ob.z * ob.z + ob.w * ob.w);
    ss += __shfl_xor(ss, 1); ss += __shfl_xor(ss, 2); ss += __shfl_xor(ss, 4);
    const float rstd = rsqrtf(ss * (1.0f / 64.0f) + EPS);
    const float* ng = a.gla_ng + l * 64 + g8 * 8;
    const v4u rr = *(const v4u*)(Z + m * ZP + ZC_GR + h * 64 + g8 * 8);
    float o[8] = {oa.x, oa.y, oa.z, oa.w, ob.x, ob.y, ob.z, ob.w};
    v4u w;
#pragma unroll
    for (int j = 0; j < 4; ++j) { const float r0 = bflo(rr[j]), r1 = bfhi(rr[j]);
        w[j] = pk2(o[2 * j] * rstd * ng[2 * j] * silu_f(r0), o[2 * j + 1] * rstd * ng[2 * j + 1] * silu_f(r1)); }
    *(v4u*)(MIX + m * 1024 + 768 + h * 64 + g8 * 8) = w;
}
__device__ __forceinline__ void phase_attn(const Args& a, int l, LAS unsigned char* lds) {
    const int tid = ltid(), G = gridDim.x;
    {
        const float* SL = (const float*)(a.ws + WS_SLOC); const float* DEC = (const float*)(a.ws + WS_DEC);
        LAS float* Sn = (LAS float*)lds;
        const int vcu0 = (G % 8 == 0) ? (int)(blockIdx.x % 8) * (G / 8) + (int)(blockIdx.x / 8) : (int)blockIdx.x;
        for (int j = vcu0; j < 256; j += G) {
            const int bh = j >> 4, n0 = 4 * (j & 15), d = tid >> 4;
            f32x4 st = (f32x4){0.f, 0.f, 0.f, 0.f};
            int nb = 0;
#pragma unroll 1
            for (; nb + 16 <= n0; nb += 16) {
                f32x4 sv[16]; float dv[16];
#pragma unroll
                for (int k = 0; k < 16; ++k) { const size_t u = (size_t)(bh * 64 + nb + k); dv[k] = DEC[u * 32 + d]; sv[k] = *(const f32x4*)(SL + u * 2048 + 4 * tid); }
#pragma unroll
                for (int k = 0; k < 16; ++k) st = dv[k] * st + sv[k];
            }
#pragma unroll 1
            for (; nb < n0; nb += 4) {
                f32x4 sv[4]; float dv[4];
#pragma unroll
                for (int k = 0; k < 4; ++k) { const size_t u = (size_t)(bh * 64 + nb + k); dv[k] = DEC[u * 32 + d]; sv[k] = *(const f32x4*)(SL + u * 2048 + 4 * tid); }
#pragma unroll
                for (int k = 0; k < 4; ++k) st = dv[k] * st + sv[k];
            }
            for (int n = n0; n < n0 + 4; ++n) { const size_t u = (size_t)(bh * 64 + n);
                *(LAS f32x4*)(Sn + 4 * tid) = st;
                __syncthreads();
                gla_fin_unit(a, l, (int)u, Sn, tid);
                __syncthreads();
                st = DEC[u * 32 + d] * st + *(const f32x4*)(SL + u * 2048 + 4 * tid); }
        }
    }
    const int vcu = (G % 8 == 0) ? (int)(blockIdx.x % 8) * (G / 8) + (int)(blockIdx.x / 8) : (int)blockIdx.x;
    for (int p = vcu; p < 256; p += G) {
        const int bh = p >> 3, s = p & 7;
        attn_unit(a, bh >> 3, bh & 7, 15 - s, lds);
        attn_unit(a, bh >> 3, bh & 7, s, lds);
    }
}
__device__ __forceinline__ void down_fixup(const Args& a, int l, int pm) {
    const float* H = (const float*)(a.ws + WS_HALO); bf16* ACT = (bf16*)(a.ws + WS_ACT);
    const float* cw = a.conv_w + (size_t)l * 3 * 5632; const float* cb = a.conv_b + (size_t)l * 5632;
    const bool first = (pm & 15) == 0;
    const float* hc = H + (size_t)pm * 4 * 5632; const float* hp = H + (size_t)(pm - 1) * 4 * 5632;
    static_assert(2 * DFF == 11 * NTHR, "down_fixup: 11 elements per thread");
#pragma unroll 1
    for (int it0 = 0; it0 < 11; it0 += 4) {
        float res[4];
#pragma unroll
        for (int q = 0; q < 4; ++q) { const int it = it0 + q; res[q] = 0.f;
            if (it < 11) { const int e = (int)threadIdx.x + it * NTHR; const int rr = e / DFF, j = e % DFF; float zc[2];
#pragma unroll
                for (int part = 0; part < 2; ++part) { const int c = part * DFF + j;
                    const float zt = hc[rr * 5632 + c];
                    const float z1 = rr == 0 ? (first ? 0.f : hp[3 * 5632 + c]) : hc[c];
                    const float z2 = first ? 0.f : (rr == 0 ? hp[2 * 5632 + c] : hp[3 * 5632 + c]);
                    zc[part] = cb[c] + cw[2 * 5632 + c] * zt + cw[5632 + c] * z1 + cw[c] * z2; }
                res[q] = zc[0] * silu_f(zc[1]); } }
#pragma unroll
        for (int q = 0; q < 4; ++q) { const int it = it0 + q; if (it < 11) { const int e = (int)threadIdx.x + it * NTHR; const int rr = e / DFF, j = e % DFF; ACT[(size_t)(pm * 256 + rr) * DFF + j] = (bf16)f2bf(res[q]); } }
    }
}
__global__ void dbg_scan(const void* p, size_t n, int kind, unsigned* flag) {
    bool bad = false;
    for (size_t i = (size_t)blockIdx.x * blockDim.x + threadIdx.x; i < n; i += (size_t)gridDim.x * blockDim.x) {
        float v = kind ? ((const float*)p)[i] : bf2f(((const bf16*)p)[i]);
        if (!(fabsf(v) < 3e4f)) bad = true;
    }
    if (bad) atomicOr(flag, 1u);
}
__global__ void dbg_out(const unsigned* flags, int nf, float* out, size_t n) {
    int code = 0;
    for (int i = nf - 1; i >= 0; --i) if (flags[i]) code = i + 1;
    const float v = 1000.0f * code;
    for (size_t i = (size_t)blockIdx.x * blockDim.x + threadIdx.x; i < n; i += (size_t)gridDim.x * blockDim.x) out[i] = v;
}
#define XB_TMO      128
#define XB_XCNT(j)  (256  + 64 * (j))
#define XB_XSUB(j)  (1280 + 64 * (j))
#define XB_XGEN(j)  (2304 + 64 * (j))
#define XB_TOP      3328
#define XB_TOPGEN   3392
#define XCD_BAR_WORDS 3456
#define XB_SPIN_CAP (1u << 18)

__device__ __forceinline__ unsigned xb_ld(unsigned* p)              { return __hip_atomic_load(p, __ATOMIC_RELAXED, __HIP_MEMORY_SCOPE_AGENT); }
__device__ __forceinline__ unsigned xb_add(unsigned* p, unsigned v) { return __hip_atomic_fetch_add(p, v, __ATOMIC_RELAXED, __HIP_MEMORY_SCOPE_AGENT); }
__device__ __forceinline__ unsigned xb_xcc_id() { return (unsigned)__builtin_amdgcn_s_getreg((3 << 11) | 20) & 0xFu; }
#define XB_SPIN(cond, bar) do { unsigned _sp = 0; while (cond) { __builtin_amdgcn_s_sleep(1); \
    if ((++_sp & 255u) == 0u) { if (xb_ld(&(bar)[XB_TMO])) break; if (_sp > XB_SPIN_CAP) { atomicAdd(&(bar)[XB_TMO], 1u); break; } } } } while (0)

struct XcdBarrier {
    unsigned* bar; unsigned x;
    volatile LAS unsigned* st;
};

__device__ __forceinline__ XcdBarrier xcd_barrier_post(unsigned* bar, volatile LAS unsigned* st) {
    XcdBarrier b; b.bar = bar; b.x = xb_xcc_id(); b.st = st;
    if (threadIdx.x == 0) (void)xb_add(&bar[XB_XCNT(b.x)], 1u);
    return b;
}
__device__ __forceinline__ void xcd_barrier_complete(unsigned* bar, unsigned x, unsigned& nloc, unsigned& nx) {
    const unsigned G = gridDim.x * gridDim.y * gridDim.z;
    unsigned sum, cnt, mine, sp = 0u;
    for (;;) {
        sum = 0u; cnt = 0u; mine = 0u;
#pragma unroll
        for (unsigned j = 0; j < 16; ++j) { const unsigned c = xb_ld(&bar[XB_XCNT(j)]); sum += c; cnt += (c > 0u) ? 1u : 0u; mine = (j == x) ? c : mine; }
        if (sum == G) break;
        __builtin_amdgcn_s_sleep(1);
        if ((++sp & 255u) == 0u) { if (xb_ld(&bar[XB_TMO])) break; if (sp > XB_SPIN_CAP) { atomicAdd(&bar[XB_TMO], 1u); break; } }
    }
    nloc = mine > 0u ? mine : 1u; nx = cnt > 0u ? cnt : 1u;
}

__device__ __forceinline__ void xcd_barrier(const XcdBarrier& b) {
    asm volatile("s_waitcnt vmcnt(0)" ::: "memory");
    __syncthreads();
    if (threadIdx.x == 0) {
        unsigned* bar = b.bar;
        __builtin_amdgcn_s_waitcnt(0);
        unsigned nloc = b.st[0], nx = b.st[1];
        if (nloc == 0u) { xcd_barrier_complete(bar, b.x, nloc, nx); b.st[0] = nloc; b.st[1] = nx; }
        const unsigned old = xb_add(&bar[XB_XSUB(b.x)], 1u);
        const unsigned gen = old / nloc;
        if (old + 1u == (gen + 1u) * nloc) {
            __builtin_amdgcn_fence(__ATOMIC_RELEASE, "agent");
            asm volatile("s_waitcnt vmcnt(0)" ::: "memory");
            const unsigned og = xb_add(&bar[XB_TOP], 1u);
            const unsigned tg = og / nx;
            if (og + 1u == (tg + 1u) * nx) xb_add(&bar[XB_TOPGEN], 1u);
            else XB_SPIN(xb_ld(&bar[XB_TOPGEN]) == tg, bar);
            __builtin_amdgcn_fence(__ATOMIC_ACQUIRE, "agent");
            xb_add(&bar[XB_XGEN(b.x)], 1u);
            asm volatile("s_waitcnt vmcnt(0)" ::: "memory");
        } else {
            XB_SPIN(xb_ld(&bar[XB_XGEN(b.x)]) == gen, bar);
            __builtin_amdgcn_fence(__ATOMIC_ACQUIRE, "agent");
            asm volatile("s_waitcnt vmcnt(0)" ::: "memory");
        }
    }
    __syncthreads();
}

constexpr int N_PHASES = 2 + 6 * DEPTH;
constexpr size_t WS_CNT = WS_BAR + 16384, WS_XBUF = 316 * MiB;
#define IN(k) (a.ph_lo <= (k) && (k) < a.ph_hi)
#ifndef EXP_DOUBLE
#define EXP_DOUBLE 0
#endif
#define BARX() do { XcdBarrier xb_; { unsigned char* wsb_ = a.ws; asm volatile("" : "+s"(wsb_)); xb_.bar = (unsigned*)(wsb_ + WS_BAR); } xb_.x = xb_xcc_id(); xb_.st = (volatile LAS unsigned*)(lds + MISC_OFF); xcd_barrier(xb_); } while (0)
#define DBL(bit, stmt) do { if ((EXP_DOUBLE >> (bit)) & 1) { stmt; BARX(); } } while (0)
#define SEAM(k) do { if (IN(k) && IN((k) + 1)) { if ((k) == -1) grid.sync(); else { XcdBarrier xb_; { unsigned char* wsb_ = a.ws; asm volatile("" : "+s"(wsb_)); xb_.bar = (unsigned*)(wsb_ + WS_BAR); } xb_.x = xb_xcc_id(); xb_.st = (volatile LAS unsigned*)(lds + MISC_OFF); xcd_barrier(xb_); } } } while (0)
template <int L> __device__ __forceinline__ void layer_phases(const Args& a, LAS unsigned char* lds, cg::grid_group& grid) {
    constexpr int P = 2 + 6 * L;
    const int G = gridDim.x;
    bf16* XN = (bf16*)(a.ws + WS_XN); bf16* Zb = (bf16*)(a.ws + WS_Z); bf16* MIX = (bf16*)(a.ws + WS_MIX); bf16* ACT = (bf16*)(a.ws + WS_ACT);
    const float* modl = (const float*)(a.ws + WS_MOD) + (size_t)L * 4 * 6144;
    const bf16* wl = (const bf16*)(a.ws + WS_W + (size_t)L * W_LAYER_BYTES);
    const float* xin = (L == 0) ? a.x : a.out;
    float* xbuf = (float*)(a.ws + WS_XBUF); unsigned* cntb = (unsigned*)(a.ws + WS_CNT);
    if (IN(P + 0)) {
        pg8::Gemm g{XN, wl + WO_IN, M, ZP, D, D}; pg8::StaticOrder S; S.init(M, ZP, G, (int)blockIdx.x);
        pg8::EpiInStat E{Zb, ZP, (float*)(a.ws + WS_STATQ), (float*)(a.ws + WS_STATKV)};
        pg8::gemm_phase<pg8::EpiInStat, pg8::StaticOrder, true, true>(lds, g, S, E);
    }
    SEAM(P + 0);
    if (IN(P + 1)) phase_mid(a, L, lds);
    SEAM(P + 1);
    if (IN(P + 2)) phase_attn(a, L, lds);
    SEAM(P + 2);
    if (IN(P + 3)) {
        pg8::Gemm g{MIX, wl + WO_OUT, M, D, D, D}; pg8::StaticOrder S; S.init(M, D, G, (int)blockIdx.x);
        pg8::EpiResNorm E{xin, a.out, modl + 2048, a.norm_ffn_g + L * D, modl + 4096, modl + 3072, XN, nullptr, xbuf, cntb + (size_t)(2 * L) * 64 * 64};
        pg8::gemm_phase<pg8::EpiResNorm, pg8::StaticOrder, false, true>(lds, g, S, E);
    }
    SEAM(P + 3);
    if (IN(P + 4)) {
        pg8::Gemm g{XN, wl + WO_UP, M, 2 * DFF, D, D}; pg8::StaticOrder S; S.init(M, 2 * DFF, G, (int)blockIdx.x);
        pg8::EpiConv E{ACT, (float*)(a.ws + WS_HALO), a.conv_w + (size_t)L * 3 * 5632, a.conv_b + (size_t)L * 5632, (LAS float*)(lds + EX_OFF)};
        pg8::gemm_phase<pg8::EpiConv, pg8::StaticOrder, true, true>(lds, g, S, E);
    }
    SEAM(P + 4);
    if (IN(P + 5)) {
        pg8::StaticOrder S; S.init(M, D, G, (int)blockIdx.x);
        { pg8::Unit u; for (int i = 0; S.next(i, u); ++i) down_fixup(a, L, u.pm); }
        __builtin_amdgcn_fence(__ATOMIC_RELEASE, "agent"); __syncthreads(); __builtin_amdgcn_fence(__ATOMIC_ACQUIRE, "agent");
        pg8::Gemm g{ACT, wl + WO_DN, M, D, DFF, DFF};
        if (L < DEPTH - 1) {
            pg8::EpiResNorm E{a.out, a.out, modl + 5120, a.norm_mix_g + (L + 1) * D, modl + 4 * 6144 + 1024, modl + 4 * 6144, XN, nullptr, xbuf, cntb + (size_t)(2 * L + 1) * 64 * 64};
            pg8::gemm_phase<pg8::EpiResNorm, pg8::StaticOrder, false, true>(lds, g, S, E);
        } else {
            pg8::EpiResNorm E{a.out, nullptr, modl + 5120, a.final_g, nullptr, nullptr, nullptr, a.out, xbuf, cntb + (size_t)(2 * L + 1) * 64 * 64};
            pg8::gemm_phase<pg8::EpiResNorm, pg8::StaticOrder, false, true>(lds, g, S, E);
        }
    }
    if (L < DEPTH - 1) SEAM(P + 5);
}
__global__ void __launch_bounds__(NTHR, 2) mk_fwd(Args a) {
    extern __shared__ __attribute__((aligned(16))) unsigned char lds_raw[];
    LAS unsigned char* lds = (LAS unsigned char*)lds_raw;
    cg::grid_group grid = cg::this_grid();
    volatile LAS unsigned* misc = (volatile LAS unsigned*)(lds + MISC_OFF);
    if (threadIdx.x < 16) misc[threadIdx.x] = 0u;
    __syncthreads();
    (void)xcd_barrier_post((unsigned*)(a.ws + WS_BAR), misc);
    if (a.ph_lo < 0) grid.sync();
    if (IN(0)) phase_prologue(a, lds);
    SEAM(0);
    if (IN(1)) phase_norm(a.x, a.norm_mix_g, (const float*)(a.ws + WS_MOD), 0, 1024, (bf16*)(a.ws + WS_XN));
    SEAM(1);
    layer_phases<0>(a, lds, grid);
    layer_phases<1>(a, lds, grid);
    layer_phases<2>(a, lds, grid);
    layer_phases<3>(a, lds, grid);
}

#ifndef MK_MULTI
#define MK_MULTI 0
#endif
extern "C" void kernel_launch(void* const* d_in, const int* in_sizes, int n_in, void* d_out, int out_size, void* d_ws, size_t ws_size, hipStream_t stream) {
    static int grid = 0;
    if (grid == 0) {
        if (n_in != 25 || out_size != M * D || ws_size < WS_XBUF + MiB) { fprintf(stderr, "kernel_launch: unexpected shapes: n_in %d out %d ws %zu (need %zu)\n", n_in, out_size, ws_size, (size_t)WS_END); grid = -1; return; }
        int dev = 0, cus = 0, per_cu = 0;
        (void)hipGetDevice(&dev);
        (void)hipDeviceGetAttribute(&cus, hipDeviceAttributeMultiprocessorCount, dev);
        if (hipFuncSetAttribute((const void*)mk_fwd, hipFuncAttributeMaxDynamicSharedMemorySize, LDS_BYTES) != hipSuccess) { fprintf(stderr, "kernel_launch: hipFuncSetAttribute failed\n"); grid = -1; return; }
        (void)hipOccupancyMaxActiveBlocksPerMultiprocessor(&per_cu, (const void*)mk_fwd, NTHR, LDS_BYTES);
        (void)hipGetLastError();
        fprintf(stderr, "kernel_launch: cus %d per_cu %d ws %zu\n", cus, per_cu, ws_size);
        grid = cus;
        if (cus != 256) { fprintf(stderr, "kernel_launch: built for a 256-CU device (one 256x256 unit per workgroup in the fused-norm GEMM phases); found %d CUs, nothing launched\n", cus); grid = -1; return; }
    }
    if (grid < 0) return;
    if (hipMemsetAsync((unsigned char*)d_ws + WS_BAR, 0, 16384 + 8 * 64 * 256, stream) != hipSuccess) { fprintf(stderr, "kernel_launch: memset failed\n"); return; }
    Args a{};
    a.x = (const float*)d_in[0]; a.c = (const float*)d_in[1]; a.pos = (const int*)d_in[2];
    a.mod_w = (const float*)d_in[3]; a.mod_b = (const float*)d_in[4]; a.norm_mix_g = (const float*)d_in[5]; a.norm_ffn_g = (const float*)d_in[6]; a.w_in = (const float*)d_in[7];
    a.q_norm_g = (const float*)d_in[8]; a.kv_norm_g = (const float*)d_in[9]; a.w_uq = (const float*)d_in[10]; a.w_ukv = (const float*)d_in[11];
    a.sg_ln_g = (const float*)d_in[12]; a.sg_ln_b = (const float*)d_in[13]; a.sg_w_s = (const float*)d_in[14]; a.sg_b_s = (const float*)d_in[15];
    a.gla_w2 = (const float*)d_in[16]; a.gla_bg = (const float*)d_in[17]; a.gla_ng = (const float*)d_in[18]; a.w_out = (const float*)d_in[19];
    a.w_up = (const float*)d_in[20]; a.conv_w = (const float*)d_in[21]; a.conv_b = (const float*)d_in[22]; a.w_down = (const float*)d_in[23]; a.final_g = (const float*)d_in[24];
    a.out = (float*)d_out; a.ws = (unsigned char*)d_ws;
#ifdef DBG_PH
    a.ph_lo = 0; a.ph_hi = DBG_PH;
    { void* args[] = {&a}; hipError_t e = hipLaunchCooperativeKernel((const void*)mk_fwd, dim3(grid), dim3(NTHR), args, LDS_BYTES, stream); if (e != hipSuccess) fprintf(stderr, "coop fail %s\n", hipGetErrorString(e)); }
    unsigned* flags = (unsigned*)((unsigned char*)d_ws + 7 * MiB);
    hipMemsetAsync(flags, 0, 256, stream);
    struct B { size_t off; size_t n; int kind; };
    const B bufs[] = { {WS_MOD, 4 * 4 * 6144, 1}, {WS_W, 11862016, 0}, {WS_XN, (size_t)M * D, 0}, {WS_Z, (size_t)M * ZP, 0}, {WS_Q, (size_t)M * 768, 0}, {WS_KN, (size_t)M * 512, 0},
        {WS_VT, (size_t)M * 512, 0}, {WS_KR, (size_t)M * 32, 0}, {WS_OINTRA, (size_t)M * 256, 1}, {WS_QT, (size_t)M * 128, 1}, {WS_SLOC, (size_t)1024 * 2048, 1}, {WS_DEC, 1024 * 32, 1},
        {WS_MIX, (size_t)M * D, 0} };
    const int nb = sizeof(bufs) / sizeof(bufs[0]);
    for (int i = 0; i < nb; ++i) hipLaunchKernelGGL(dbg_scan, dim3(1024), dim3(256), 0, stream, (const void*)((unsigned char*)d_ws + bufs[i].off), bufs[i].n, bufs[i].kind, flags + i);
    hipLaunchKernelGGL(dbg_scan, dim3(1024), dim3(256), 0, stream, (const void*)d_out, (size_t)M * D, 1, flags + nb);
    hipLaunchKernelGGL(dbg_out, dim3(1024), dim3(256), 0, stream, (const unsigned*)flags, nb + 1, (float*)d_out, (size_t)M * D);
#elif MK_MULTI
    for (int ph = 0; ph < N_PHASES; ++ph) { a.ph_lo = ph; a.ph_hi = ph + 1; hipLaunchKernelGGL(mk_fwd, dim3(grid), dim3(NTHR), LDS_BYTES, stream, a); }
#else
    a.ph_lo = 0; a.ph_hi = N_PHASES;
    void* args[] = {&a};
    hipError_t e = hipLaunchCooperativeKernel((const void*)mk_fwd, dim3(grid), dim3(NTHR), args, LDS_BYTES, stream);
    if (e != hipSuccess) fprintf(stderr, "kernel_launch: cooperative launch failed: %s (grid %d)\n", hipGetErrorString(e), grid);
#endif
}
```

```cpp
#include <hip/hip_runtime.h>
#include <hip/hip_cooperative_groups.h>
#include <cstdio>
#include <cstdint>
namespace cg = cooperative_groups;
__device__ __forceinline__ int ltid() { int t = threadIdx.x; asm volatile("" : "+v"(t)); return t; }
namespace pg8 {
#define PG8_LAS __attribute__((address_space(3)))
typedef unsigned short bf16_t;
typedef short bf16x8 __attribute__((ext_vector_type(8)));
typedef float f32x4 __attribute__((ext_vector_type(4)));
typedef unsigned u32x4 __attribute__((ext_vector_type(4)));
constexpr int BM = 256, BK = 64, HALF = 128, HTB = HALF * BK * 2  , STAGE_BYTES = 8 * HTB, NXCD = 8, WGM = 4;

__host__ __device__ __forceinline__ int lds_byte(int r, int c) { const int st = (r >> 4) * 2 + (c >> 5), rr = r & 15, cc = c & 31, ob = rr * 64 + cc * 2; return st * 1024 + (ob ^ (((ob >> 9) & 1) << 5)); }
__host__ __device__ __forceinline__ void stage_rc(int b, int& R, int& C) { const int st = b / 1024, sb = b % 1024, swz = sb ^ (((sb >> 9) & 1) << 5); R = (st >> 1) * 16 + swz / 64; C = (st & 1) * 32 + (swz % 64) / 2; }
__host__ __device__ __forceinline__ int perm32(int rho) { const int n = rho >> 4, i = rho & 15; return 8 * (i >> 2) + 4 * n + (i & 3); }

struct Unit { int pm, pn; };
struct Gemm { const bf16_t* A; const bf16_t* Bt; int M, N, K, lda; };

struct StaticOrder {
    int nM, nN, nwg, G, c;
    __host__ __device__ void init(int M, int N, int G_, int c_) { nM = M / BM; nN = N / BM; nwg = nM * nN; G = G_; c = c_; }
    __host__ __device__ bool next(int i, Unit& u) const {
        const long L = (long)i * G + c; if (L >= nwg) return false;
        int wgid = (int)L; { const int q = nwg / NXCD, r = nwg % NXCD, xcd = wgid % NXCD, off = wgid / NXCD; wgid = (xcd < r ? xcd * (q + 1) : r * (q + 1) + (xcd - r) * q) + off; }
        const int nig = WGM * nN, gid = wgid / nig, fm = gid * WGM, gsz = (nM - fm) < WGM ? (nM - fm) : WGM;
        u.pm = fm + ((wgid % nig) % gsz); u.pn = (wgid % nig) / gsz; return true;
    }
    __device__ __forceinline__ void a_ready(const Unit&) const {}
    __device__ __forceinline__ void done(const Unit&) const {}
};

__device__ __forceinline__ unsigned cvt_pk_bf16(float lo, float hi) { unsigned r; asm volatile("v_cvt_pk_bf16_f32 %0, %1, %2" : "=v"(r) : "v"(lo), "v"(hi)); return r; }
typedef float f32x2c_t __attribute__((ext_vector_type(2))); typedef __bf16 bf16x2c_t __attribute__((ext_vector_type(2)));
__device__ __forceinline__ unsigned cvt_pk_bf16_safe(float lo, float hi) { f32x2c_t v = {lo, hi}; bf16x2c_t b = __builtin_convertvector(v, bf16x2c_t); return __builtin_bit_cast(unsigned, b); }
typedef float f32x2 __attribute__((ext_vector_type(2)));
template <int ACT  > struct EpiBf16 {
    static constexpr bool PERM = true, AFTER_DRAIN = false; static_assert(ACT == 0 || ACT == 1, "EpiBf16: ACT is 0 (none) or 1 (gelu_pk)");
    bf16_t* O; int ldc; const float* bias; int split_cols; size_t split_stride; float scale0;
    __device__ __forceinline__ void operator()(const f32x4 (&acc)[2][2][4][2], const Unit& u, int wr, int wc, int fr, int fq) const {
        const int row0 = u.pm * BM + wr * 64 + fr; int colt = u.pn * BM; bf16_t* base = O;
        float sc = 1.f; if (split_cols) { const int t = colt / split_cols; base += (size_t)t * split_stride; colt -= t * split_cols; if (t == 0) sc = scale0; }
        const int col0 = colt + wc * 32 + 8 * fq, bcol0 = u.pn * BM + wc * 32 + 8 * fq;
        f32x4 bv[2][2];
#pragma unroll
        for (int bj = 0; bj < 2; ++bj)
#pragma unroll
            for (int n = 0; n < 2; ++n) bv[bj][n] = bias ? *(const f32x4*)(bias + bcol0 + bj * HALF + 4 * n) : (f32x4){0.f, 0.f, 0.f, 0.f};
#pragma unroll
        for (int ai = 0; ai < 2; ++ai)
#pragma unroll
            for (int m = 0; m < 4; ++m) { bf16_t* rowp = base + (size_t)(row0 + ai * HALF + m * 16) * ldc + col0;
#pragma unroll
                for (int bj = 0; bj < 2; ++bj) { f32x4 v0 = acc[ai][bj][m][0] + bv[bj][0], v1 = acc[ai][bj][m][1] + bv[bj][1];
                    v0 = v0 * sc; v1 = v1 * sc; u32x4 w; w.x = cvt_pk_bf16(v0[0], v0[1]); w.y = cvt_pk_bf16(v0[2], v0[3]); w.z = cvt_pk_bf16(v1[0], v1[1]); w.w = cvt_pk_bf16(v1[2], v1[3]);
                    *(u32x4*)(rowp + bj * HALF) = w; } }
    }
};
struct EpiRes {
    static constexpr bool PERM = false, AFTER_DRAIN = false;
    const float* base; float* out; const float* gate;
    __device__ __forceinline__ void operator()(const f32x4 (&acc)[2][2][4][2], const Unit& u, int wr, int wc, int fr, int fq) const {
        const int row0 = u.pm * BM + wr * 64 + fr, col0 = u.pn * BM + wc * 32 + 4 * fq;
        const float* gp = gate + (size_t)(u.pm >> 4) * 6144 + col0;
        f32x4 gv[2][2];
#pragma unroll
        for (int bj = 0; bj < 2; ++bj)
#pragma unroll
            for (int n = 0; n < 2; ++n) gv[bj][n] = *(const f32x4*)(gp + bj * HALF + n * 16);
#pragma unroll
        for (int ai = 0; ai < 2; ++ai)
#pragma unroll
            for (int m = 0; m < 4; ++m) { const size_t off = (size_t)(row0 + ai * HALF + m * 16) * 1024 + col0;
#pragma unroll
                for (int bj = 0; bj < 2; ++bj)
#pragma unroll
                    for (int n = 0; n < 2; ++n) { const f32x4 bs = *(const f32x4*)(base + off + bj * HALF + n * 16);
                        *(f32x4*)(out + off + bj * HALF + n * 16) = bs + gv[bj][n] * acc[ai][bj][m][n]; } }
    }
};
__device__ __forceinline__ float dpp_prev1(float prev, float cur) {
    const int t = __builtin_amdgcn_update_dpp(0, __float_as_int(prev), 0x121, 0xf, 0xf, false);
    return __int_as_float(__builtin_amdgcn_update_dpp(t, __float_as_int(cur), 0x111, 0xf, 0xf, false));
}
__device__ __forceinline__ float dpp_prev2(float prev, float cur) {
    const int t = __builtin_amdgcn_update_dpp(0, __float_as_int(prev), 0x122, 0xf, 0xf, false);
    return __int_as_float(__builtin_amdgcn_update_dpp(t, __float_as_int(cur), 0x112, 0xf, 0xf, false));
}
struct EpiConv {
    static constexpr bool PERM = true, AFTER_DRAIN = false;
    unsigned short* act; float* halo; const float* cw; const float* cb; PG8_LAS float* ex;
    __device__ __forceinline__ void operator()(const f32x4 (&acc)[2][2][4][2], const Unit& u, int wr, int wc, int fr, int fq) const {
        const int jj0 = wc * 32 + 8 * fq;
        if (fr >= 14) {
#pragma unroll
            for (int ai = 0; ai < 2; ++ai)
#pragma unroll
                for (int bj = 0; bj < 2; ++bj)
#pragma unroll
                    for (int n = 0; n < 2; ++n) *(PG8_LAS f32x4*)(ex + ((ai * 2 + wr) * 2 + (fr - 14)) * 256 + bj * 128 + jj0 + 4 * n) = acc[ai][bj][3][n];
        }
        float* hb = halo + (size_t)u.pm * 4 * 5632 + u.pn * 128 + jj0;
        if (wr == 0 && fr < 2) {
#pragma unroll
            for (int bj = 0; bj < 2; ++bj)
#pragma unroll
                for (int n = 0; n < 2; ++n) *(f32x4*)(hb + fr * 5632 + bj * 2816 + 4 * n) = acc[0][bj][0][n];
        }
        if (wr == 1 && fr >= 14) {
#pragma unroll
            for (int bj = 0; bj < 2; ++bj)
#pragma unroll
                for (int n = 0; n < 2; ++n) *(f32x4*)(hb + (fr - 12) * 5632 + bj * 2816 + 4 * n) = acc[1][bj][3][n];
        }
        asm volatile("s_waitcnt lgkmcnt(0)" ::: "memory"); __builtin_amdgcn_s_barrier(); asm volatile("" ::: "memory");
#pragma unroll
        for (int n = 0; n < 2; ++n) {
            const int vc = u.pn * 128 + jj0 + 4 * n;
            const f32x4 w0v = *(const f32x4*)(cw + vc), w1v = *(const f32x4*)(cw + 5632 + vc), w2v = *(const f32x4*)(cw + 11264 + vc), cbv = *(const f32x4*)(cb + vc);
            const f32x4 w0g = *(const f32x4*)(cw + 2816 + vc), w1g = *(const f32x4*)(cw + 5632 + 2816 + vc), w2g = *(const f32x4*)(cw + 11264 + 2816 + vc), cbg = *(const f32x4*)(cb + 2816 + vc);
#pragma unroll
            for (int ai = 0; ai < 2; ++ai) {
                f32x4 pv = (f32x4){0.f, 0.f, 0.f, 0.f}, pg = pv;
                const int pslot = ai * 2 + wr - 1;
                if (pslot >= 0) { pv = *(const PG8_LAS f32x4*)(ex + (pslot * 2 + (fr & 1)) * 256 + jj0 + 4 * n); pg = *(const PG8_LAS f32x4*)(ex + (pslot * 2 + (fr & 1)) * 256 + 128 + jj0 + 4 * n); }
#pragma unroll
                for (int m = 0; m < 4; ++m) {
                    const f32x4 cv = acc[ai][0][m][n], cg = acc[ai][1][m][n]; float o[4];
#pragma unroll
                    for (int i = 0; i < 4; ++i) {
                        const float v1 = dpp_prev1(pv[i], cv[i]), v2 = dpp_prev2(pv[i], cv[i]), g1 = dpp_prev1(pg[i], cg[i]), g2 = dpp_prev2(pg[i], cg[i]);
                        const float val = cbv[i] + w2v[i] * cv[i] + w1v[i] * v1 + w0v[i] * v2;
                        const float gat = cbg[i] + w2g[i] * cg[i] + w1g[i] * g1 + w0g[i] * g2;
                        o[i] = val * gat * __builtin_amdgcn_rcpf(1.0f + __builtin_amdgcn_exp2f(-1.4426950408889634f * gat));
                    }
                    typedef unsigned u32x2v __attribute__((ext_vector_type(2)));
                    u32x2v w; w.x = cvt_pk_bf16(o[0], o[1]); w.y = cvt_pk_bf16(o[2], o[3]);
                    *(u32x2v*)(act + (size_t)(u.pm * BM + ai * HALF + wr * 64 + m * 16 + fr) * 2816 + vc) = w;
                    pv = cv; pg = cg;
                }
            }
        }
    }
};
struct EpiInStat {
    static constexpr bool PERM = true, AFTER_DRAIN = false;
    bf16_t* O; int ldc; float* statq; float* statkv;
    __device__ __forceinline__ void operator()(const f32x4 (&acc)[2][2][4][2], const Unit& u, int wr, int wc, int fr, int fq) const {
        const int row0 = u.pm * BM + wr * 64 + fr, col0 = u.pn * BM + wc * 32 + 8 * fq;
        float one = 1.0f; asm volatile("" : "+v"(one));
#pragma unroll
        for (int ai = 0; ai < 2; ++ai)
#pragma unroll
            for (int m = 0; m < 4; ++m) { const int row = row0 + ai * HALF + m * 16; bf16_t* rowp = O + (size_t)row * ldc + col0; float s[2];
#pragma unroll
                for (int bj = 0; bj < 2; ++bj) { const f32x4 v0 = acc[ai][bj][m][0] * one, v1 = acc[ai][bj][m][1] * one;
                    u32x4 w; w.x = cvt_pk_bf16(v0[0], v0[1]); w.y = cvt_pk_bf16(v0[2], v0[3]); w.z = cvt_pk_bf16(v1[0], v1[1]); w.w = cvt_pk_bf16(v1[2], v1[3]);
                    *(u32x4*)(rowp + bj * HALF) = w;
                    float q = 0.f;
#pragma unroll
                    for (int j = 0; j < 4; ++j) { const float lo = __builtin_bit_cast(float, w[j] << 16), hh = __builtin_bit_cast(float, w[j] & 0xffff0000u); q += lo * lo + hh * hh; }
                    s[bj] = q; }
                if (u.pn <= 1) { float t = (u.pn == 0) ? s[0] + s[1] : s[0]; t += __shfl_xor(t, 16); t += __shfl_xor(t, 32);
                    if (fq == 0) { float* sp = (u.pn == 0) ? statq : statkv; sp[(size_t)row * 4 + wc] = t; } } }
    }
};
struct EpiRow {
    static constexpr bool PERM = true, AFTER_DRAIN = false;
    bf16_t* O; int ldc; const float* stat; float invk;
    __device__ __forceinline__ void operator()(const f32x4 (&acc)[2][2][4][2], const Unit& u, int wr, int wc, int fr, int fq) const {
        const int row0 = u.pm * BM + wr * 64 + fr, col0 = u.pn * BM + wc * 32 + 8 * fq;
#pragma unroll
        for (int ai = 0; ai < 2; ++ai)
#pragma unroll
            for (int m = 0; m < 4; ++m) { const int row = row0 + ai * HALF + m * 16; const f32x4 st = *(const f32x4*)(stat + (size_t)row * 4);
                const float rstd = rsqrtf(((st.x + st.y) + (st.z + st.w)) * invk + 1e-6f); bf16_t* rowp = O + (size_t)row * ldc + col0;
#pragma unroll
                for (int bj = 0; bj < 2; ++bj) { const f32x4 v0 = acc[ai][bj][m][0] * rstd, v1 = acc[ai][bj][m][1] * rstd;
                    u32x4 w; w.x = cvt_pk_bf16(v0[0], v0[1]); w.y = cvt_pk_bf16(v0[2], v0[3]); w.z = cvt_pk_bf16(v1[0], v1[1]); w.w = cvt_pk_bf16(v1[2], v1[3]);
                    *(u32x4*)(rowp + bj * HALF) = w; } }
    }
};
struct EpiQ {
    static constexpr bool PERM = false, AFTER_DRAIN = false;
    bf16_t* Q; const float* stat; const float* rc; const float* rs; float qscale;
    __device__ __forceinline__ void operator()(const f32x4 (&acc)[2][2][4][2], const Unit& u, int wr, int wc, int fr, int fq) const {
        typedef unsigned u32x2v __attribute__((ext_vector_type(2)));
        asm volatile("" : "+v"(fr), "+v"(fq));
        const int row0 = u.pm * BM + wr * 64 + fr;
#pragma unroll
        for (int ai = 0; ai < 2; ++ai)
#pragma unroll
            for (int m = 0; m < 4; ++m) { const int row = row0 + ai * HALF + m * 16; const f32x4 st = *(const f32x4*)(stat + (size_t)row * 4);
                const float rstd = rsqrtf(((st.x + st.y) + (st.z + st.w)) * (1.0f / 256.0f) + 1e-6f) * qscale;
#pragma unroll
                for (int bj = 0; bj < 2; ++bj) { const int gb = 8 * u.pn + 4 * bj + wc; f32x4 v0 = acc[ai][bj][m][0] * rstd, v1 = acc[ai][bj][m][1] * rstd;
                    if (gb % 3 == 2) { const f32x4 cc = *(const f32x4*)(rc + (size_t)row * 16 + 4 * fq), ss = *(const f32x4*)(rs + (size_t)row * 16 + 4 * fq);
                        const f32x4 t1 = v0, t2 = v1; v0 = t1 * cc - t2 * ss; v1 = t1 * ss + t2 * cc; }
                    bf16_t* qp = Q + (size_t)row * 768 + 32 * gb + 4 * fq;
                    u32x2v w0, w1; w0.x = cvt_pk_bf16(v0[0], v0[1]); w0.y = cvt_pk_bf16(v0[2], v0[3]); w1.x = cvt_pk_bf16(v1[0], v1[1]); w1.y = cvt_pk_bf16(v1[2], v1[3]);
                    *(u32x2v*)qp = w0; *(u32x2v*)(qp + 16) = w1; }
                asm volatile("" ::: "memory"); }
    }
};
struct EpiResNorm {
    static constexpr bool PERM = false, AFTER_DRAIN = true;
    const float* base; float* xout; const float* gate; const float* g; const float* sc; const float* sh; bf16_t* xn; float* fout; float* xbuf; unsigned* cnt;
    __device__ __forceinline__ void fused(f32x4 (&acc)[2][2][4][2], const Unit& u, int wr, int wc, int fr, int fq, PG8_LAS unsigned char* lds, int wid, int lane) const {
        PG8_LAS float* P = (PG8_LAS float*)lds;
        PG8_LAS float* S = (PG8_LAS float*)(lds + 4096);
        const int col0 = u.pn * BM + wc * 32 + 4 * fq, bidx = u.pm >> 4;
        const float* gp = gate + (size_t)bidx * 6144 + col0;
        f32x4 gv[2][2];
#pragma unroll
        for (int bj = 0; bj < 2; ++bj)
#pragma unroll
            for (int n = 0; n < 2; ++n) gv[bj][n] = *(const f32x4*)(gp + bj * HALF + n * 16);
#pragma unroll
        for (int ai = 0; ai < 2; ++ai)
#pragma unroll
            for (int m = 0; m < 4; ++m) { const int r = ai * HALF + wr * 64 + m * 16 + fr; const size_t off = (size_t)(u.pm * BM + r) * 1024 + col0; float s = 0.f;
#pragma unroll
                for (int bj = 0; bj < 2; ++bj)
#pragma unroll
                    for (int n = 0; n < 2; ++n) { const f32x4 bs = *(const f32x4*)(base + off + bj * HALF + n * 16); const f32x4 x = bs + gv[bj][n] * acc[ai][bj][m][n];
                        acc[ai][bj][m][n] = x; if (xout) *(f32x4*)(xout + off + bj * HALF + n * 16) = x; s += (x[0] * x[0] + x[1] * x[1]) + (x[2] * x[2] + x[3] * x[3]); }
                s += __shfl_xor(s, 16); s += __shfl_xor(s, 32);
                if (fq == 0) P[r * 4 + wc] = s;
                asm volatile("" : "+v"(acc[ai][0][m][0]), "+v"(acc[ai][0][m][1]), "+v"(acc[ai][1][m][0]), "+v"(acc[ai][1][m][1]));
                if (m & 1) asm volatile("" ::: "memory"); }
        asm volatile("s_waitcnt lgkmcnt(0)" ::: "memory"); __builtin_amdgcn_s_barrier(); asm volatile("" ::: "memory");
        const int row = wid * 32 + (lane & 31);
        if (lane < 32) { const f32x4 p4 = *(const PG8_LAS f32x4*)(P + row * 4);
            __hip_atomic_store(xbuf + ((size_t)(u.pm * BM + row) * 4 + u.pn), (p4.x + p4.y) + (p4.z + p4.w), __ATOMIC_RELAXED, __HIP_MEMORY_SCOPE_AGENT); }
        asm volatile("s_waitcnt vmcnt(0)" ::: "memory");
        if (lane == 0) __hip_atomic_fetch_add(cnt + 64 * u.pm, 1u, __ATOMIC_RELAXED, __HIP_MEMORY_SCOPE_AGENT);
        if (wid == 0) {
            unsigned spins = 0;
            while ((unsigned)__builtin_amdgcn_readfirstlane(__hip_atomic_load(cnt + 64 * u.pm, __ATOMIC_RELAXED, __HIP_MEMORY_SCOPE_AGENT)) < 32u) { __builtin_amdgcn_s_sleep(2); if (++spins > (1u << 22)) break; }
            __builtin_amdgcn_fence(__ATOMIC_ACQUIRE, "agent");
        }
        asm volatile("s_waitcnt vmcnt(0) lgkmcnt(0)" ::: "memory"); __builtin_amdgcn_s_barrier(); asm volatile("" ::: "memory");
        if (lane < 32) { const float* slot = xbuf + (size_t)(u.pm * BM + row) * 4; float t = 0.f;
#pragma unroll
            for (int k = 0; k < 4; ++k) t += __hip_atomic_load(slot + k, __ATOMIC_RELAXED, __HIP_MEMORY_SCOPE_AGENT);
            S[row] = rsqrtf(t * (1.0f / 1024.0f) + 1e-6f); }
        asm volatile("s_waitcnt lgkmcnt(0)" ::: "memory"); __builtin_amdgcn_s_barrier(); asm volatile("" ::: "memory");
        typedef unsigned u32x2v __attribute__((ext_vector_type(2)));
#pragma unroll
        for (int bj = 0; bj < 2; ++bj)
#pragma unroll
            for (int n = 0; n < 2; ++n) { const int c = col0 + bj * HALF + n * 16; const f32x4 gg = *(const f32x4*)(g + c);
                f32x4 mul = gg, add = (f32x4){0.f, 0.f, 0.f, 0.f};
                if (xn) { mul = gg * (*(const f32x4*)(sc + (size_t)bidx * 6144 + c) + 1.0f); add = *(const f32x4*)(sh + (size_t)bidx * 6144 + c); }
#pragma unroll
                for (int ai = 0; ai < 2; ++ai)
#pragma unroll
                    for (int m = 0; m < 4; ++m) { const int r = ai * HALF + wr * 64 + m * 16 + fr; const float rstd = S[r]; const size_t off = (size_t)(u.pm * BM + r) * 1024 + c;
                        const f32x4 y = acc[ai][bj][m][n] * rstd * mul + add;
                        if (xn) { u32x2v w; w.x = cvt_pk_bf16(y[0], y[1]); w.y = cvt_pk_bf16(y[2], y[3]); *(u32x2v*)(xn + off) = w; }
                        else *(f32x4*)(fout + off) = y; } }
    }
};
template <class Epi, class Sched, bool ALIGN_EPI = false, bool SP2 = false>
__device__ __forceinline__ void gemm_phase(PG8_LAS unsigned char* lds, const Gemm g, const Sched& S, const Epi& E) {
    const int tid = ltid(), wid = __builtin_amdgcn_readfirstlane(tid >> 6), lane = tid & 63, wr = wid >> 2, wc = wid & 3, fr = lane & 15, fq = lane >> 4;
    const int K = g.K, nt = K / BK, lda = g.lda;
    unsigned voffA[2], voffB[2];
#pragma unroll
    for (int i = 0; i < 2; ++i) { int R, C; stage_rc(tid * 16 + i * 8192, R, C); const int Rb = Epi::PERM ? ((R & ~31) + perm32(R & 31)) : R;
        voffA[i] = (unsigned)(R * lda + C) * 2u; voffB[i] = (unsigned)(Rb * K + C) * 2u; }
    const size_t kstep = (size_t)(BK * 2);
    const size_t hstepA = (size_t)HALF * lda * 2, tstepA = 2 * hstepA;
    const size_t hstep = (size_t)HALF * K * 2;
    const size_t tstep = 2 * hstep;
    const unsigned ldsw = (unsigned)wid * 1024u;
    const int aoff = lds_byte(wr * 64 + fr, fq * 8), boff = lds_byte(wc * 32 + fr, fq * 8);
#define PG8_SA(b, h) (((b) * 2 + (h)) * HTB)
#define PG8_SB(b, h) ((4 + (b) * 2 + (h)) * HTB)
#define PG8_STAGE(bufoff, gbase, voff) do { _Pragma("unroll") for (int _i = 0; _i < 2; ++_i) \
        __builtin_amdgcn_global_load_lds((const unsigned*)((const char*)(gbase) + (voff)[_i]), (PG8_LAS unsigned*)(lds + (bufoff) + ldsw + _i * 8192), 16, 0, 0); } while (0)
#define PG8_LDA(dst, b, h) do { _Pragma("unroll") for (int m = 0; m < 4; ++m) _Pragma("unroll") for (int k = 0; k < 2; ++k) dst[m][k] = *(const PG8_LAS bf16x8*)(lds + PG8_SA(b, h) + aoff + m * 2048 + k * 1024); } while (0)
#define PG8_LDB(dst, b, h) do { _Pragma("unroll") for (int n = 0; n < 2; ++n) _Pragma("unroll") for (int k = 0; k < 2; ++k) dst[n][k] = *(const PG8_LAS bf16x8*)(lds + PG8_SB(b, h) + boff + n * 2048 + k * 1024); } while (0)
#define PG8_MMA(ai, bj, At, Bt) do { __builtin_amdgcn_s_setprio(1); _Pragma("unroll") for (int m = 0; m < 4; ++m) _Pragma("unroll") for (int n = 0; n < 2; ++n) _Pragma("unroll") for (int k = 0; k < 2; ++k) \
        acc[ai][bj][m][n] = __builtin_amdgcn_mfma_f32_16x16x32_bf16(Bt[n][k], At[m][k], acc[ai][bj][m][n], 0, 0, 0); __builtin_amdgcn_s_setprio(0); } while (0)
#define PG8_WAIT_V(n) asm volatile("s_waitcnt vmcnt(" #n ")" ::: "memory")
#define PG8_WAIT_L(n) asm volatile("s_waitcnt lgkmcnt(" #n ")" ::: "memory")
#define PG8_BAR __builtin_amdgcn_s_barrier()
#define PG8_SCHED __builtin_amdgcn_sched_barrier(0)
    Unit cur, nxt; int ui = 0;
    if (!S.next(0, cur)) return;
    f32x4 acc[2][2][4][2];
#pragma unroll
    for (int a = 0; a < 2; ++a)
#pragma unroll
        for (int b = 0; b < 2; ++b)
#pragma unroll
            for (int m = 0; m < 4; ++m)
#pragma unroll
                for (int n = 0; n < 2; ++n) acc[a][b][m][n] = (f32x4){0.f, 0.f, 0.f, 0.f};
    bf16x8 At[4][2], B0[2][2], B1[2][2];
    const char* cA = (const char*)g.A + (size_t)cur.pm * tstepA; const char* cB = (const char*)g.Bt + (size_t)cur.pn * tstep;
    S.a_ready(cur);
    if constexpr (SP2) {
        PG8_STAGE(PG8_SB(0, 0), cB, voffB); PG8_STAGE(PG8_SB(0, 1), cB + hstep, voffB); PG8_STAGE(PG8_SA(0, 0), cA, voffA); PG8_STAGE(PG8_SA(0, 1), cA + hstepA, voffA);
        if (wr == 1) PG8_BAR;
        PG8_WAIT_V(2); PG8_BAR;
        PG8_STAGE(PG8_SB(1, 0), cB + kstep, voffB); PG8_STAGE(PG8_SA(1, 0), cA + kstep, voffA); PG8_STAGE(PG8_SB(1, 1), cB + hstep + kstep, voffB);
        PG8_WAIT_V(6); PG8_BAR;
    } else {
        PG8_STAGE(PG8_SB(0, 0), cB, voffB); PG8_STAGE(PG8_SA(0, 0), cA, voffA); PG8_STAGE(PG8_SB(0, 1), cB + hstep, voffB); PG8_STAGE(PG8_SA(0, 1), cA + hstepA, voffA);
        if (wr == 1) PG8_BAR;
        PG8_WAIT_V(4); PG8_BAR;
        PG8_STAGE(PG8_SB(1, 0), cB + kstep, voffB); PG8_STAGE(PG8_SA(1, 0), cA + kstep, voffA); PG8_STAGE(PG8_SB(1, 1), cB + hstep + kstep, voffB);
        PG8_WAIT_V(6); PG8_BAR;
    }
    for (;;) {
        const bool has_next = S.next(ui + 1, nxt);
        const char* nA = has_next ? (const char*)g.A + (size_t)nxt.pm * tstepA : cA; const char* nB = has_next ? (const char*)g.Bt + (size_t)nxt.pn * tstep : cB;
        for (int t = 0; t < nt; t += 2) {
            const bool last = (t == nt - 2);
            const char* a1 = cA + (size_t)(t + 1) * kstep;
            const char* a2 = last ? nA : cA + (size_t)(t + 2) * kstep; const char* b2 = last ? nB : cB + (size_t)(t + 2) * kstep;
            const char* a3 = a2 + kstep; const char* b3 = b2 + kstep;
            if (last && has_next) S.a_ready(nxt);
            if constexpr (SP2) {
            PG8_LDB(B0, 0, 0); PG8_LDB(B1, 0, 1); PG8_SCHED; PG8_LDA(At, 0, 0); PG8_STAGE(PG8_SA(1, 1), a1 + hstepA, voffA);
            PG8_WAIT_V(8); PG8_WAIT_L(0); PG8_BAR; PG8_MMA(0, 0, At, B0); PG8_MMA(0, 1, At, B1); PG8_BAR; PG8_SCHED;
            PG8_LDA(At, 0, 1); PG8_STAGE(PG8_SB(0, 0), b2, voffB); PG8_STAGE(PG8_SB(0, 1), b2 + hstep, voffB); PG8_STAGE(PG8_SA(0, 0), a2, voffA);
            PG8_WAIT_V(8); PG8_WAIT_L(0); PG8_BAR; PG8_MMA(1, 0, At, B0); PG8_MMA(1, 1, At, B1); PG8_BAR; PG8_SCHED;
            PG8_LDB(B0, 1, 0); PG8_LDB(B1, 1, 1); PG8_SCHED; PG8_LDA(At, 1, 0); PG8_STAGE(PG8_SA(0, 1), a2 + hstepA, voffA);
            PG8_WAIT_V(8); PG8_WAIT_L(0); PG8_BAR; PG8_MMA(0, 0, At, B0); PG8_MMA(0, 1, At, B1); PG8_BAR; PG8_SCHED;
            PG8_LDA(At, 1, 1); PG8_STAGE(PG8_SB(1, 0), b3, voffB); PG8_STAGE(PG8_SB(1, 1), b3 + hstep, voffB); PG8_STAGE(PG8_SA(1, 0), a3, voffA);
            PG8_WAIT_V(8); PG8_WAIT_L(0); PG8_BAR; PG8_MMA(1, 0, At, B0); PG8_MMA(1, 1, At, B1); PG8_BAR; PG8_SCHED;
            } else {
            PG8_LDB(B0, 0, 0); PG8_SCHED; PG8_LDA(At, 0, 0); PG8_STAGE(PG8_SA(1, 1), a1 + hstepA, voffA);
            PG8_WAIT_L(8); PG8_BAR; PG8_WAIT_L(0); PG8_MMA(0, 0, At, B0); PG8_BAR; PG8_SCHED;
            PG8_LDB(B1, 0, 1); PG8_STAGE(PG8_SB(0, 0), b2, voffB);
            PG8_BAR; PG8_WAIT_L(0); PG8_MMA(0, 1, At, B1); PG8_BAR;
            PG8_LDA(At, 0, 1); PG8_STAGE(PG8_SA(0, 0), a2, voffA);
            PG8_BAR; PG8_WAIT_L(0); PG8_MMA(1, 0, At, B0); PG8_BAR; PG8_SCHED;
            PG8_STAGE(PG8_SB(0, 1), b2 + hstep, voffB);
            PG8_WAIT_V(6); PG8_BAR; PG8_MMA(1, 1, At, B1); PG8_BAR;
            PG8_LDB(B0, 1, 0); PG8_SCHED; PG8_LDA(At, 1, 0); PG8_STAGE(PG8_SA(0, 1), a2 + hstepA, voffA);
            PG8_WAIT_L(8); PG8_BAR; PG8_WAIT_L(0); PG8_MMA(0, 0, At, B0); PG8_BAR; PG8_SCHED;
            PG8_LDB(B1, 1, 1); PG8_STAGE(PG8_SB(1, 0), b3, voffB);
            PG8_BAR; PG8_WAIT_L(0); PG8_MMA(0, 1, At, B1); PG8_BAR;
            PG8_LDA(At, 1, 1); PG8_STAGE(PG8_SA(1, 0), a3, voffA);
            PG8_BAR; PG8_WAIT_L(0); PG8_MMA(1, 0, At, B0); PG8_BAR; PG8_SCHED;
            PG8_STAGE(PG8_SB(1, 1), b3 + hstep, voffB);
            PG8_WAIT_V(6); PG8_BAR; PG8_MMA(1, 1, At, B1); PG8_BAR;
            }
        }
        if constexpr (ALIGN_EPI) { if (wr == 0) PG8_BAR; }
        if constexpr (!Epi::AFTER_DRAIN) { E(acc, cur, wr, wc, fr, fq); S.done(cur); }
        if (!has_next) break;
#pragma unroll
        for (int a = 0; a < 2; ++a)
#pragma unroll
            for (int b = 0; b < 2; ++b)
#pragma unroll
                for (int m = 0; m < 4; ++m)
#pragma unroll
                    for (int n = 0; n < 2; ++n) acc[a][b][m][n] = (f32x4){0.f, 0.f, 0.f, 0.f};
        cur = nxt; cA = nA; cB = nB; ++ui;
        if constexpr (ALIGN_EPI) { if (wr == 1) PG8_BAR; }
    }
    PG8_WAIT_V(0);
    if constexpr (!ALIGN_EPI) { if (wr == 0) PG8_BAR; }
    PG8_BAR;
    if constexpr (Epi::AFTER_DRAIN) { E.fused(acc, cur, wr, wc, fr, fq, lds, wid, lane); S.done(cur); }
#undef PG8_SA
#undef PG8_SB
#undef PG8_STAGE
#undef PG8_LDA
#undef PG8_LDB
#undef PG8_MMA
#undef PG8_WAIT_V
#undef PG8_WAIT_L
#undef PG8_BAR
#undef PG8_SCHED
}
}
#define LAS __attribute__((address_space(3)))
typedef unsigned short bf16;
typedef unsigned v4u __attribute__((ext_vector_type(4)));
typedef unsigned v2u __attribute__((ext_vector_type(2)));
typedef float f32x4 __attribute__((ext_vector_type(4)));
typedef float f32x16 __attribute__((ext_vector_type(16)));
typedef short bf16x8 __attribute__((ext_vector_type(8)));
typedef short s16x4 __attribute__((ext_vector_type(4)));
#define MFMA32(a, b, c) __builtin_amdgcn_mfma_f32_32x32x16_bf16((a), (b), (c), 0, 0, 0)
#define LDS_WAIT() asm volatile("s_waitcnt lgkmcnt(0)" ::: "memory")

constexpr int NWAVES = 8, NTHR = 512;
constexpr int M = 16384, D = 1024, SEQ = 4096, NBATCH = 4, DEPTH = 4;
constexpr int ZP = 1792;
constexpr int DFF = 2816;
constexpr float EPS = 1e-6f;
constexpr float QSCALE = 0.10206207261596575f * 1.4426950408889634f;
constexpr int ZC_CQ = 0, ZC_CKV = 256, ZC_KR = 384, ZC_SU = 416, ZC_SV = 672, ZC_GQ = 928, ZC_GK = 1056, ZC_GV = 1184, ZC_GLR = 1440, ZC_GR = 1456;
constexpr size_t MiB = 1u << 20;
constexpr size_t WS_MOD = 0, WS_HALO = 1 * MiB, WS_W = 8 * MiB, W_LAYER_BYTES = 23 * MiB;
constexpr size_t WS_XN = 100 * MiB, WS_Z = 132 * MiB, WS_Q = 188 * MiB, WS_KN = 212 * MiB, WS_VT = 228 * MiB, WS_KR = 244 * MiB, WS_ACT = 132 * MiB;
constexpr size_t WS_MIX = 246 * MiB, WS_OINTRA = 278 * MiB, WS_QT = 294 * MiB, WS_SLOC = 302 * MiB, WS_DEC = 310 * MiB;
constexpr size_t WS_KVB = 212 * MiB;
constexpr size_t WS_STATQ = 311 * MiB, WS_STATKV = 312 * MiB, WS_ROPEC = 313 * MiB, WS_ROPES = 314 * MiB, WS_END = 315 * MiB;
constexpr size_t WO_IN = 0, WO_UQ = 1835008, WO_UKV = 2031616, WO_OUT = 2162688, WO_UP = 3211264, WO_DN = 8978432;
constexpr int LDS_BYTES = 147456, EX_OFF = 131072, MISC_OFF = EX_OFF + 8192;
constexpr size_t WS_BAR = 7 * MiB;

struct Args {
    const float *x, *c; const int* pos;
    const float *mod_w, *mod_b, *norm_mix_g, *norm_ffn_g, *w_in, *q_norm_g, *kv_norm_g, *w_uq, *w_ukv, *sg_ln_g, *sg_ln_b, *sg_w_s, *sg_b_s, *gla_w2, *gla_bg, *gla_ng,
                *w_out, *w_up, *conv_w, *conv_b, *w_down, *final_g;
    float* out; unsigned char* ws; int ph_lo, ph_hi;
};

__device__ __forceinline__ unsigned f2bf(float f) { unsigned u = __builtin_bit_cast(unsigned, f); return (u + 0x7fffu + ((u >> 16) & 1u)) >> 16; }
__device__ __forceinline__ unsigned pk2(float lo, float hi) { return pg8::cvt_pk_bf16(lo, hi); }
__device__ __forceinline__ unsigned pk2s(float lo, float hi) { return pg8::cvt_pk_bf16_safe(lo, hi); }
__device__ __forceinline__ float bf2f(unsigned short h) { return __builtin_bit_cast(float, (unsigned)h << 16); }
__device__ __forceinline__ float bflo(unsigned w) { return __builtin_bit_cast(float, w << 16); }
__device__ __forceinline__ float bfhi(unsigned w) { return __builtin_bit_cast(float, w & 0xffff0000u); }
__device__ __forceinline__ int crow(int r, int hi) { return (r & 3) + 8 * (r >> 2) + 4 * hi; }
__device__ __forceinline__ float wave_sum(float v) {
#pragma unroll
    for (int o = 1; o < 64; o <<= 1) v += __shfl_xor(v, o);
    return v;
}
__device__ __forceinline__ float gelu_tanh(float x) {
    const float y = 0.7978845608028654f * (x + 0.044715f * x * x * x);
    const float e = __builtin_amdgcn_exp2f(2.8853900817779268f * y);
    return x * (1.0f - __builtin_amdgcn_rcpf(e + 1.0f));
}
__device__ __forceinline__ float silu_f(float x) { return x / (1.0f + __expf(-x)); }

__device__ __forceinline__ void transpose_item(const float* W, int K, int N, bf16* WT, int item, int nblk, int mode, const float* gk, LAS float* scr, int lane) {
    const int kb = item / nblk, nb = item % nblk, k0 = 64 * kb, n0 = 32 * nb;
    float tv[32];
#pragma unroll
    for (int i = 0; i < 32; ++i) { const int kk = 2 * i + (lane >> 5); const int n = n0 + (lane & 31); tv[i] = (n < N) ? __builtin_nontemporal_load(W + (size_t)(k0 + kk) * N + n) : 0.f; }
#pragma unroll
    for (int i = 0; i < 32; ++i) { const int kk = 2 * i + (lane >> 5); float v = tv[i]; if (gk) v *= gk[k0 + kk]; scr[kk * 33 + (lane & 31)] = v; }
    LDS_WAIT();
    const int c = lane & 7;
    int rbase = n0;
    if (mode == 1) { if (n0 < DFF) rbase = 256 * (n0 / 128) + (n0 % 128); else { const int n1 = n0 - DFF; rbase = 256 * (n1 / 128) + 128 + (n1 % 128); } }
#pragma unroll
    for (int j = 0; j < 4; ++j) { const int n = (lane >> 3) + 8 * j; const LAS float* s = scr + (8 * c) * 33 + n;
        v4u o; o.x = pk2(s[0 * 33], s[1 * 33]); o.y = pk2(s[2 * 33], s[3 * 33]); o.z = pk2(s[4 * 33], s[5 * 33]); o.w = pk2(s[6 * 33], s[7 * 33]);
        *(v4u*)(WT + (size_t)(rbase + n) * K + k0 + 8 * c) = o; }
    LDS_WAIT();
}
__device__ __forceinline__ void phase_prologue(const Args& a, LAS unsigned char* lds) {
    const int tid = ltid(), lane = tid & 63, wave = tid >> 6, G = gridDim.x;
    LAS float* cact = (LAS float*)lds; LAS float* red = (LAS float*)(lds + 16384);
    for (int i = tid; i < 4096; i += NTHR) cact[i] = silu_f(a.c[i]);
    __syncthreads();
    float* MOD = (float*)(a.ws + WS_MOD);
    for (int it = blockIdx.x; it < 192; it += G) {
        const int l = it / 48, n0 = (it % 48) * 128, half = (tid >> 5) & 1, l32 = tid & 31;
        f32x4 acc[4];
#pragma unroll
        for (int b = 0; b < 4; ++b) acc[b] = (f32x4){0.f, 0.f, 0.f, 0.f};
        const float* wp = a.mod_w + (size_t)l * 1024 * 6144 + n0 + 4 * l32;
#pragma unroll 4
        for (int i = 0; i < 64; ++i) { const int k = wave * 128 + 2 * i + half; const f32x4 wv = __builtin_nontemporal_load((const f32x4*)(wp + (size_t)k * 6144));
#pragma unroll
            for (int b = 0; b < 4; ++b) acc[b] += cact[b * 1024 + k] * wv; }
        const int pidx = wave * 2 + half;
#pragma unroll
        for (int b = 0; b < 4; ++b) *(LAS f32x4*)(red + (pidx * 4 + b) * 128 + 4 * l32) = acc[b];
        __syncthreads();
        { const int b = tid >> 7, col = tid & 127; float s = a.mod_b[l * 6144 + n0 + col];
#pragma unroll
            for (int p = 0; p < 16; ++p) s += red[(p * 4 + b) * 128 + col];
            MOD[(size_t)(l * 4 + b) * 6144 + n0 + col] = s; }
        __syncthreads();
    }
    __syncthreads();
    { float* RC = (float*)(a.ws + WS_ROPEC); float* RS = (float*)(a.ws + WS_ROPES);
      for (int e = blockIdx.x * NTHR + tid; e < M * 16; e += G * NTHR) { const int f = e & 15; const float inv = exp2f(-(float)f * (13.287712379549449f / 16.0f)); float s_, c_;
          sincosf((float)a.pos[e >> 4] * inv, &s_, &c_); RC[e] = c_; RS[e] = s_; } }
    LAS float* scr = (LAS float*)(lds + wave * 16384);
    const int gw = blockIdx.x * NWAVES + wave, NGW = G * NWAVES;
    constexpr int I_IN = 16 * 56, I_UQ = 4 * 24, I_UKV = 2 * 32, I_OUT = 16 * 32, I_UP = 16 * 176, I_DN = 44 * 32, I_L = I_IN + I_UQ + I_UKV + I_OUT + I_UP + I_DN;
    for (int it = gw; it < DEPTH * I_L; it += NGW) {
        const int l = it / I_L; int r = it % I_L;
        bf16* wl = (bf16*)(a.ws + WS_W + (size_t)l * W_LAYER_BYTES);
        if (r < I_IN) { transpose_item(a.w_in + (size_t)l * 1024 * 1712, 1024, 1712, wl + WO_IN, r, 56, 0, nullptr, scr, lane); continue; } r -= I_IN;
        if (r < I_UQ) { transpose_item(a.w_uq + (size_t)l * 256 * 768, 256, 768, wl + WO_UQ, r, 24, 0, a.q_norm_g + l * 256, scr, lane); continue; } r -= I_UQ;
        if (r < I_UKV) { transpose_item(a.w_ukv + (size_t)l * 128 * 1024, 128, 1024, wl + WO_UKV, r, 32, 0, a.kv_norm_g + l * 128, scr, lane); continue; } r -= I_UKV;
        if (r < I_OUT) { transpose_item(a.w_out + (size_t)l * 1024 * 1024, 1024, 1024, wl + WO_OUT, r, 32, 0, nullptr, scr, lane); continue; } r -= I_OUT;
        if (r < I_UP) { transpose_item(a.w_up + (size_t)l * 1024 * 5632, 1024, 5632, wl + WO_UP, r, 176, 1, nullptr, scr, lane); continue; } r -= I_UP;
        transpose_item(a.w_down + (size_t)l * 2816 * 1024, 2816, 1024, wl + WO_DN, r, 32, 0, nullptr, scr, lane);
    }
}

__device__ __forceinline__ void phase_norm(const float* x, const float* g, const float* modl, int sh_off, int sc_off, bf16* XN) {
    const int tid = ltid(), lane = tid & 63, wave = tid >> 6;
    const int gw = blockIdx.x * NWAVES + wave, NGW = gridDim.x * NWAVES;
    for (int m = gw; m < M; m += NGW) {
        const f32x4* xr = (const f32x4*)(x + (size_t)m * D) + lane;
        f32x4 v[4]; float s = 0.f;
#pragma unroll
        for (int j = 0; j < 4; ++j) { v[j] = xr[64 * j]; s += (v[j].x * v[j].x + v[j].y * v[j].y) + (v[j].z * v[j].z + v[j].w * v[j].w); }
        const float rstd = rsqrtf(wave_sum(s) * (1.f / D) + EPS);
        const float* mb = modl + (size_t)(m >> 12) * 6144;
#pragma unroll
        for (int j = 0; j < 4; ++j) { const int col = 4 * lane + 256 * j;
            const f32x4 gg = *(const f32x4*)(g + col), sc = *(const f32x4*)(mb + sc_off + col), sh = *(const f32x4*)(mb + sh_off + col);
            const f32x4 y = v[j] * rstd * gg * (sc + 1.0f) + sh;
            v2u o; o.x = pk2(y.x, y.y); o.y = pk2(y.z, y.w);
            *(v2u*)(XN + (size_t)m * D + col) = o; }
    }
}
__device__ __forceinline__ void phase_final_norm(float* x, const float* g) {
    const int tid = ltid(), lane = tid & 63, wave = tid >> 6;
    const int gw = blockIdx.x * NWAVES + wave, NGW = gridDim.x * NWAVES;
    for (int m = gw; m < M; m += NGW) {
        f32x4* xr = (f32x4*)(x + (size_t)m * D) + lane;
        f32x4 v[4]; float s = 0.f;
#pragma unroll
        for (int j = 0; j < 4; ++j) { v[j] = xr[64 * j]; s += (v[j].x * v[j].x + v[j].y * v[j].y) + (v[j].z * v[j].z + v[j].w * v[j].w); }
        const float rstd = rsqrtf(wave_sum(s) * (1.f / D) + EPS);
#pragma unroll
        for (int j = 0; j < 4; ++j) { const f32x4 gg = *(const f32x4*)(g + 4 * lane + 256 * j); xr[64 * j] = v[j] * rstd * gg; }
    }
}
__device__ __forceinline__ void p3_sgu(const Args& a, int l, int unit, LAS unsigned char* lds) {
    const int tid = ltid(), lane = tid & 63, wave = tid >> 6, hi = lane >> 5, m0 = (unit >> 1) * 128, hp = unit & 1;
    const bf16* Z = (const bf16*)(a.ws + WS_Z); bf16* MIX = (bf16*)(a.ws + WS_MIX);
    LAS bf16* vT = (LAS bf16*)lds;
    const int h = 2 * hp + (wave >> 2), j4 = wave & 3;
    const float* Wh = a.sg_w_s + ((size_t)(l * 4 + h)) * 128 * 128; const float* bs = a.sg_b_s + (l * 4 + h) * 128;
    { const int s = tid >> 2, qd = tid & 3; const bf16* zr = Z + (size_t)(m0 + s) * ZP + ZC_SV + 64 * qd;
      float v[64]; float sum = 0.f;
#pragma unroll
      for (int c8 = 0; c8 < 8; ++c8) { const v4u raw = *(const v4u*)(zr + 8 * c8);
#pragma unroll
          for (int j = 0; j < 4; ++j) { const float x0 = gelu_tanh(bflo(raw[j])), x1 = gelu_tanh(bfhi(raw[j])); v[8 * c8 + 2 * j] = x0; v[8 * c8 + 2 * j + 1] = x1; sum += x0 + x1; } }
      sum += __shfl_xor(sum, 1); sum += __shfl_xor(sum, 2);
      const float mean = sum * (1.0f / 256.0f); float q = 0.f;
#pragma unroll
      for (int c = 0; c < 64; ++c) { const float d_ = v[c] - mean; q += d_ * d_; }
      q += __shfl_xor(q, 1); q += __shfl_xor(q, 2);
      const float rstd = rsqrtf(q * (1.0f / 256.0f) + EPS);
      if ((qd >> 1) == hp) { const float* lg = a.sg_ln_g + l * 256 + 64 * qd; const float* lb = a.sg_ln_b + l * 256 + 64 * qd; LAS bf16* vq = vT + (64 * (qd & 1)) * 136 + s;
#pragma unroll
          for (int c = 0; c < 64; ++c) vq[c * 136] = (bf16)f2bf((v[c] - mean) * rstd * lg[c] + lb[c]); }
    }
    __syncthreads();
#pragma unroll
    for (int tl = 0; tl < 2; ++tl) {
        const int tb = tl ? 3 - j4 : j4, cl = 32 * tl + (lane & 31), ch = 64 * h + cl, t = 32 * tb + (lane & 31);
        f32x16 acc = {};
        bf16 su[16];
#pragma unroll
        for (int r = 0; r < 16; ++r) su[r] = Z[(size_t)(m0 + 32 * tb + crow(r, hi)) * ZP + ZC_SU + ch];
        float bsv[16];
#pragma unroll
        for (int g4 = 0; g4 < 4; ++g4) { const f32x4 b4 = *(const f32x4*)(bs + 32 * tb + 8 * g4 + 4 * hi); bsv[4 * g4] = b4.x; bsv[4 * g4 + 1] = b4.y; bsv[4 * g4 + 2] = b4.z; bsv[4 * g4 + 3] = b4.w; }
        f32x4 w0[8], w1[8];
#pragma unroll
        for (int ks = 0; ks < 8; ++ks) if (ks < 2 * (tb + 1)) { const int s0 = 16 * ks + 8 * hi; w0[ks] = *(const f32x4*)(Wh + t * 128 + s0); w1[ks] = *(const f32x4*)(Wh + t * 128 + s0 + 4); }
#pragma unroll
        for (int ks = 0; ks < 8; ++ks) if (ks < 2 * (tb + 1)) {
            const int s0 = 16 * ks + 8 * hi;
            v4u af; af.x = pk2s(s0 + 0 <= t ? w0[ks].x : 0.f, s0 + 1 <= t ? w0[ks].y : 0.f); af.y = pk2s(s0 + 2 <= t ? w0[ks].z : 0.f, s0 + 3 <= t ? w0[ks].w : 0.f);
            af.z = pk2s(s0 + 4 <= t ? w1[ks].x : 0.f, s0 + 5 <= t ? w1[ks].y : 0.f); af.w = pk2s(s0 + 6 <= t ? w1[ks].z : 0.f, s0 + 7 <= t ? w1[ks].w : 0.f);
            const bf16x8 bfr = *(const LAS bf16x8*)(vT + (64 * (wave >> 2) + cl) * 136 + s0);
            acc = MFMA32(__builtin_bit_cast(bf16x8, af), bfr, acc);
        }
#pragma unroll
        for (int r = 0; r < 16; ++r) { const int tt = 32 * tb + crow(r, hi); const size_t m = (size_t)(m0 + tt);
            const float u = gelu_tanh(bf2f(su[r])); MIX[m * 1024 + 512 + ch] = (bf16)f2bf(u * (acc[r] + bsv[r])); }
    }
    __syncthreads();
}
constexpr int GW_QS = 0, GW_KS = 5120, GW_KD = 10240, GW_VT = 14848, GW_BB = 24064, GW_BYTES = 24064 + 64 * 33 * 4;
__device__ __forceinline__ void p3_gla_stage1(const Args& a, int l, int unit, LAS unsigned char* wl, int lane, int half) {
    asm volatile("" : "+v"(lane));
    const int bh = unit >> 6, n = unit & 63, b = bh >> 2, h = bh & 3, m0 = b * SEQ + 64 * n, d0 = 16 * half;
    const bf16* Z = (const bf16*)(a.ws + WS_Z); const bf16* zr = Z + (size_t)(m0 + lane) * ZP;
    float* QT = (float*)(a.ws + WS_QT); float* DEC = (float*)(a.ws + WS_DEC);
    LAS bf16* Qs = (LAS bf16*)(wl + GW_QS); LAS bf16* Ks = (LAS bf16*)(wl + GW_KS); LAS bf16* KdT = (LAS bf16*)(wl + GW_KD); LAS bf16* Vt = (LAS bf16*)(wl + GW_VT);
    LAS float* bbL = (LAS float*)(wl + GW_BB) + lane * 33;
    v4u qraw[2], kraw[2];
#pragma unroll
    for (int c = 0; c < 2; ++c) { qraw[c] = *(const v4u*)(zr + ZC_GQ + h * 32 + d0 + 8 * c); kraw[c] = *(const v4u*)(zr + ZC_GK + h * 32 + d0 + 8 * c); }
    {
#pragma unroll
        for (int c8 = 0; c8 < 4; ++c8) { const int cc = 32 * half + 8 * c8; const v4u raw = *(const v4u*)(zr + ZC_GV + h * 64 + cc);
#pragma unroll
            for (int j = 0; j < 4; ++j) { Vt[(cc + 2 * j) * 72 + lane] = (bf16)(raw[j] & 0xffffu); Vt[(cc + 2 * j + 1) * 72 + lane] = (bf16)(raw[j] >> 16); } }
    }
    {
        float g[16];
        { const v4u r0 = *(const v4u*)(zr + ZC_GLR), r1 = *(const v4u*)(zr + ZC_GLR + 8);
#pragma unroll
          for (int j = 0; j < 4; ++j) { g[2 * j] = bflo(r0[j]); g[2 * j + 1] = bfhi(r0[j]); g[8 + 2 * j] = bflo(r1[j]); g[8 + 2 * j + 1] = bfhi(r1[j]); } }
        const float* w2 = a.gla_w2 + (size_t)l * 2048 + h * 32 + d0; const float* bg = a.gla_bg + l * 128 + h * 32 + d0;
#pragma unroll 4
        for (int d = 0; d < 16; ++d) { float x = bg[d];
#pragma unroll
            for (int r = 0; r < 16; ++r) x += g[r] * w2[r * 128 + d];
            bbL[d0 + d] = (fminf(x, 0.f) - __logf(1.0f + __expf(-fabsf(x)))) * (1.0f / 16.0f); }
    }
#pragma unroll 8
    for (int d = 0; d < 16; ++d) { float v = bbL[d0 + d];
#pragma unroll
        for (int off = 1; off < 64; off <<= 1) { const float t = __int_as_float(__builtin_amdgcn_ds_bpermute(((lane - off) & 63) << 2, __float_as_int(v))); if (lane >= off) v += t; }
        bbL[d0 + d] = v; }
    LDS_WAIT(); __builtin_amdgcn_wave_barrier();
    {
        const LAS float* blL = (const LAS float*)(wl + GW_BB) + 63 * 33;
        float* qtp = QT + (size_t)(m0 + lane) * 128 + h * 32 + d0;
#pragma unroll
        for (int c = 0; c < 2; ++c) { float qv[8], kt[8]; v4u qo, ko;
#pragma unroll
            for (int j = 0; j < 4; ++j) {
#pragma unroll
                for (int e = 0; e < 2; ++e) { const int d = d0 + 8 * c + 2 * j + e; const float q = e ? bfhi(qraw[c][j]) : bflo(qraw[c][j]), k = e ? bfhi(kraw[c][j]) : bflo(kraw[c][j]);
                    const float bv = bbL[d], bl = blL[d];
                    qv[2 * j + e] = q * 0.17677669529663687f * __expf(bv); kt[2 * j + e] = k * __expf(-bv);
                    KdT[d * 72 + lane] = (bf16)f2bf(k * __expf(bl - bv)); } }
#pragma unroll
            for (int j = 0; j < 4; ++j) { qo[j] = pk2s(qv[2 * j], qv[2 * j + 1]); ko[j] = pk2s(kt[2 * j], kt[2 * j + 1]); }
            *(LAS v4u*)(Qs + lane * 40 + d0 + 8 * c) = qo; *(LAS v4u*)(Ks + lane * 40 + d0 + 8 * c) = ko;
            *(f32x4*)(qtp + 8 * c) = (f32x4){qv[0], qv[1], qv[2], qv[3]}; *(f32x4*)(qtp + 8 * c + 4) = (f32x4){qv[4], qv[5], qv[6], qv[7]}; }
        if (lane < 16) DEC[(size_t)unit * 32 + d0 + lane] = __expf(blL[d0 + lane]);
    }
}
__device__ __forceinline__ void p3_gla_stage2(const Args& a, int unit, LAS unsigned char* wl, int lane, int half) {
    asm volatile("" : "+v"(lane));
    const int hi = lane >> 5, r32 = lane & 31;
    const int bh = unit >> 6, n = unit & 63, b = bh >> 2, h = bh & 3, m0 = b * SEQ + 64 * n;
    float* OI = (float*)(a.ws + WS_OINTRA); float* SL = (float*)(a.ws + WS_SLOC);
    LAS bf16* Qs = (LAS bf16*)(wl + GW_QS); LAS bf16* Ks = (LAS bf16*)(wl + GW_KS); LAS bf16* KdT = (LAS bf16*)(wl + GW_KD); LAS bf16* Vt = (LAS bf16*)(wl + GW_VT);
    if (half == 0) {
        f32x16 st00 = {}, st01 = {}, st11 = {};
#pragma unroll
        for (int ks = 0; ks < 2; ++ks) {
            const bf16x8 k0 = *(const LAS bf16x8*)(Ks + r32 * 40 + 16 * ks + 8 * hi), k1 = *(const LAS bf16x8*)(Ks + (32 + r32) * 40 + 16 * ks + 8 * hi);
            const bf16x8 q0 = *(const LAS bf16x8*)(Qs + r32 * 40 + 16 * ks + 8 * hi), q1 = *(const LAS bf16x8*)(Qs + (32 + r32) * 40 + 16 * ks + 8 * hi);
            st00 = MFMA32(k0, q0, st00); st01 = MFMA32(k0, q1, st01); st11 = MFMA32(k1, q1, st11);
        }
#pragma unroll
        for (int r = 0; r < 16; ++r) if (crow(r, hi) > r32) { st00[r] = 0.f; st11[r] = 0.f; }
        f32x16 o00 = {}, o01 = {}, o10 = {}, o11 = {};
#pragma unroll
        for (int kk = 0; kk < 2; ++kk) {
            v4u p00, p01, p11;
#pragma unroll
            for (int j = 0; j < 4; ++j) { const int r = 8 * kk + 2 * j; p00[j] = pk2s(st00[r], st00[r + 1]); p01[j] = pk2s(st01[r], st01[r + 1]); p11[j] = pk2s(st11[r], st11[r + 1]); }
#pragma unroll
            for (int cb = 0; cb < 2; ++cb) {
                const LAS bf16* vp = Vt + (32 * cb + r32) * 72 + 16 * kk + 4 * hi;
                const s16x4 a0 = *(const LAS s16x4*)(vp), a1 = *(const LAS s16x4*)(vp + 8), c0 = *(const LAS s16x4*)(vp + 32), c1 = *(const LAS s16x4*)(vp + 40);
                const bf16x8 vj0 = (bf16x8){a0[0], a0[1], a0[2], a0[3], a1[0], a1[1], a1[2], a1[3]}, vj1 = (bf16x8){c0[0], c0[1], c0[2], c0[3], c1[0], c1[1], c1[2], c1[3]};
                if (cb == 0) { o00 = MFMA32(__builtin_bit_cast(bf16x8, p00), vj0, o00); o10 = MFMA32(__builtin_bit_cast(bf16x8, p01), vj0, o10); o10 = MFMA32(__builtin_bit_cast(bf16x8, p11), vj1, o10); }
                else         { o01 = MFMA32(__builtin_bit_cast(bf16x8, p00), vj0, o01); o11 = MFMA32(__builtin_bit_cast(bf16x8, p01), vj0, o11); o11 = MFMA32(__builtin_bit_cast(bf16x8, p11), vj1, o11); }
            }
        }
        float* ob = OI + (size_t)(m0 + 4 * hi) * 256 + h * 64 + r32;
#pragma unroll
        for (int r = 0; r < 16; ++r) { float* op = ob + ((r & 3) + 8 * (r >> 2)) * 256;
            op[0] = o00[r]; op[32] = o01[r]; op[32 * 256] = o10[r]; op[32 * 256 + 32] = o11[r];
            if ((r & 3) == 3) asm volatile("" ::: "memory"); }
    } else {
        f32x16 s0 = {}, s1 = {};
#pragma unroll
        for (int ks = 0; ks < 4; ++ks) {
            const bf16x8 af = *(const LAS bf16x8*)(KdT + r32 * 72 + 16 * ks + 8 * hi);
            const bf16x8 b0 = *(const LAS bf16x8*)(Vt + r32 * 72 + 16 * ks + 8 * hi), b1 = *(const LAS bf16x8*)(Vt + (32 + r32) * 72 + 16 * ks + 8 * hi);
            s0 = MFMA32(af, b0, s0); s1 = MFMA32(af, b1, s1);
        }
        float* sb = SL + (size_t)unit * 2048 + 4 * hi * 64 + r32;
#pragma unroll
        for (int r = 0; r < 16; ++r) { float* sp = sb + ((r & 3) + 8 * (r >> 2)) * 64; sp[0] = s0[r]; sp[32] = s1[r]; if ((r & 3) == 3) asm volatile("" ::: "memory"); }
    }
}
#ifndef EXP_GLA_REP
#define EXP_GLA_REP 1
#endif
#ifndef EXP_SGU_REP
#define EXP_SGU_REP 1
#endif
__device__ __forceinline__ void phase_mid(const Args& a, int l, LAS unsigned char* lds) {
    const int G = gridDim.x;
    const bf16* wl = (const bf16*)(a.ws + WS_W + (size_t)l * W_LAYER_BYTES);
    const bf16* Z = (const bf16*)(a.ws + WS_Z);
    {
        pg8::Gemm g{Z + ZC_CQ, wl + WO_UQ, M, 768, 256, ZP}; pg8::StaticOrder S; S.init(M, 768, G, (int)blockIdx.x);
        pg8::EpiQ E{(bf16*)(a.ws + WS_Q), (const float*)(a.ws + WS_STATQ), (const float*)(a.ws + WS_ROPEC), (const float*)(a.ws + WS_ROPES), QSCALE};
        pg8::gemm_phase<pg8::EpiQ, pg8::StaticOrder, true, true>(lds, g, S, E);
    }
    {
        pg8::Gemm g{Z + ZC_CKV, wl + WO_UKV, M, 1024, 128, ZP}; pg8::StaticOrder S; S.init(M, 1024, G, (int)blockIdx.x);
        pg8::EpiRow E{(bf16*)(a.ws + WS_KVB), 1024, (const float*)(a.ws + WS_STATKV), 1.0f / 128.0f};
        pg8::gemm_phase<pg8::EpiRow, pg8::StaticOrder, true, true>(lds, g, S, E);
    }
    {
        const int tid = ltid(); bf16* KR = (bf16*)(a.ws + WS_KR); const float* RC = (const float*)(a.ws + WS_ROPEC); const float* RS = (const float*)(a.ws + WS_ROPES);
        for (int e = blockIdx.x * NTHR + tid; e < M * 16; e += G * NTHR) { const int m = e >> 4, f = e & 15;
            const float t1 = bf2f(Z[(size_t)m * ZP + ZC_KR + f]), t2 = bf2f(Z[(size_t)m * ZP + ZC_KR + 16 + f]), c_ = RC[e], s_ = RS[e];
            KR[(size_t)m * 32 + f] = (bf16)f2bf(t1 * c_ - t2 * s_); KR[(size_t)m * 32 + 16 + f] = (bf16)f2bf(t1 * s_ + t2 * c_); }
    }
    for (int rep = 0; rep < EXP_SGU_REP; ++rep)
    for (int u = blockIdx.x; u < 256; u += G) p3_sgu(a, l, u, lds);
    __syncthreads();
    { const int tid = ltid(), wave = __builtin_amdgcn_readfirstlane(tid >> 6), pr = wave >> 1, half = wave & 1;
      for (int rep = 0; rep < EXP_GLA_REP; ++rep) for (int u0 = blockIdx.x * 4; u0 < 1024; u0 += G * 4) {
          p3_gla_stage1(a, l, u0 + pr, lds + pr * GW_BYTES, tid & 63, half);
          __syncthreads();
          p3_gla_stage2(a, u0 + pr, lds + pr * GW_BYTES, tid & 63, half);
          __syncthreads(); } }
    __syncthreads();
}
constexpr int KS_PITCH = 104, VS_PITCH = 72, KS_BYTES = 64 * KS_PITCH * 2, VS_BYTES = 64 * VS_PITCH * 2, ABUF = KS_BYTES + VS_BYTES, WSF_OFF = 2 * ABUF;
__device__ __forceinline__ void attn_unit(const Args& a, int b, int h, int qb, LAS unsigned char* lds) {
    const int tid = ltid(), lane = tid & 63, wave = tid >> 6, hi = lane >> 5, r32 = lane & 31;
    const bf16* Q = (const bf16*)(a.ws + WS_Q); const bf16* KVB = (const bf16*)(a.ws + WS_KVB); const bf16* KR = (const bf16*)(a.ws + WS_KR);
    bf16* MIX = (bf16*)(a.ws + WS_MIX);
    const int rowbase = b * SEQ, q0 = qb * 256, qrow = q0 + 32 * wave + r32, NT = 4 * (qb + 1);
    LAS float* wsf = (LAS float*)(lds + WSF_OFF) + wave * 32;
    bf16x8 qf[6];
#pragma unroll
    for (int ks = 0; ks < 6; ++ks) qf[ks] = *(const bf16x8*)(Q + (size_t)(rowbase + qrow) * 768 + h * 96 + 16 * ks + 8 * hi);
    const bf16* ksrc = KVB + (size_t)(rowbase + (tid >> 3)) * 1024 + h * 128 + 8 * (tid & 7);
    const bf16* rsrc = KR + (size_t)(rowbase + ((tid & 255) >> 2)) * 32 + 8 * (tid & 3);
    const bf16* vsrc = KVB + (size_t)(rowbase + lane) * 1024 + h * 128 + 64 + 8 * wave;
    const int kdst = (tid >> 3) * KS_PITCH * 2 + 16 * (tid & 7), rdst = ((tid & 255) >> 2) * KS_PITCH * 2 + 128 + 16 * (tid & 3), vdst = KS_BYTES + (8 * wave) * VS_PITCH * 2 + 2 * ((lane & ~12) | ((lane & 4) << 1) | ((lane & 8) >> 1));
    v4u kreg, rreg, vreg;
#define VST(base, v) do { _Pragma("unroll") for (int j_ = 0; j_ < 4; ++j_) { *(LAS bf16*)((base) + vdst + (2 * j_) * VS_PITCH * 2) = (bf16)((v)[j_] & 0xffffu); *(LAS bf16*)((base) + vdst + (2 * j_ + 1) * VS_PITCH * 2) = (bf16)((v)[j_] >> 16); } } while (0)
    kreg = *(const v4u*)ksrc; if (tid < 256) rreg = *(const v4u*)rsrc; vreg = *(const v4u*)vsrc;
    *(LAS v4u*)(lds + kdst) = kreg; if (tid < 256) *(LAS v4u*)(lds + rdst) = rreg; VST(lds, vreg);
    __syncthreads();
    float m_run = -1e30f, l_run = 0.f; f32x16 o0 = {}, o1 = {};
    for (int t = 0; t < NT; ++t) {
        const bool more = (t + 1 < NT);
        if (more) { kreg = *(const v4u*)(ksrc + (size_t)(t + 1) * 64 * 1024); if (tid < 256) rreg = *(const v4u*)(rsrc + (size_t)(t + 1) * 64 * 32); vreg = *(const v4u*)(vsrc + (size_t)(t + 1) * 64 * 1024); }
        if (64 * t <= q0 + 32 * wave + 31) {
            LAS const unsigned char* kb = lds + (t & 1) * ABUF; LAS const unsigned char* vb = kb + KS_BYTES;
            f32x16 s0 = {}, s1 = {};
            bf16x8 kf0[6], kf1[6], vf0[4], vf1[4];
#pragma unroll
            for (int ks = 0; ks < 6; ++ks) { kf0[ks] = *(const LAS bf16x8*)(kb + r32 * KS_PITCH * 2 + 32 * ks + 16 * hi); kf1[ks] = *(const LAS bf16x8*)(kb + (32 + r32) * KS_PITCH * 2 + 32 * ks + 16 * hi); }
#pragma unroll
            for (int kk = 0; kk < 4; ++kk) { vf0[kk] = *(const LAS bf16x8*)(vb + r32 * VS_PITCH * 2 + 32 * kk + 16 * hi); vf1[kk] = *(const LAS bf16x8*)(vb + (32 + r32) * VS_PITCH * 2 + 32 * kk + 16 * hi); }
            __builtin_amdgcn_sched_barrier(0);
#pragma unroll
            for (int ks = 0; ks < 6; ++ks) { s0 = MFMA32(kf0[ks], qf[ks], s0); s1 = MFMA32(kf1[ks], qf[ks], s1); }
            if (64 * t + 63 > q0 + 32 * wave) {
#pragma unroll
                for (int r = 0; r < 16; ++r) { const int key = 64 * t + crow(r, hi); if (key > qrow) s0[r] = -1e30f; if (key + 32 > qrow) s1[r] = -1e30f; }
            }
            float mx = fmaxf(s0[0], s1[0]);
#pragma unroll
            for (int r = 1; r < 16; ++r) mx = fmaxf(mx, fmaxf(s0[r], s1[r]));
            { const auto rr_ = __builtin_amdgcn_permlane32_swap(__float_as_uint(mx), __float_as_uint(mx), false, false); mx = fmaxf(__uint_as_float(rr_[0]), __uint_as_float(rr_[1])); }
            const float m_new = (mx > m_run + 8.0f) ? mx : m_run;
            const float alpha = __builtin_amdgcn_exp2f(m_run - m_new);
            const bool resc = __any(m_new != m_run);
            m_run = m_new;
            float rs = 0.f;
#pragma unroll
            for (int r = 0; r < 16; ++r) { s0[r] = __builtin_amdgcn_exp2f(s0[r] - m_new); s1[r] = __builtin_amdgcn_exp2f(s1[r] - m_new); rs += s0[r] + s1[r]; }
            l_run = l_run * alpha + rs;
            if (resc) {
                if (hi == 0) wsf[r32] = alpha;
                LDS_WAIT();
#pragma unroll
                for (int g4 = 0; g4 < 4; ++g4) { const f32x4 al = *(const LAS f32x4*)(wsf + 8 * g4 + 4 * hi);
#pragma unroll
                    for (int i = 0; i < 4; ++i) { o0[4 * g4 + i] *= al[i]; o1[4 * g4 + i] *= al[i]; } }
                LDS_WAIT();
            }
            bf16x8 pa[4];
#pragma unroll
            for (int kk = 0; kk < 4; ++kk) { v4u p;
#pragma unroll
                for (int j = 0; j < 4; ++j) { const int r = 8 * (kk & 1) + 2 * j; p[j] = (kk < 2) ? pk2s(s0[r], s0[r + 1]) : pk2s(s1[r], s1[r + 1]); }
                pa[kk] = __builtin_bit_cast(bf16x8, p); }
#pragma unroll
            for (int kk = 0; kk < 4; ++kk) { o0 = MFMA32(pa[kk], vf0[kk], o0); o1 = MFMA32(pa[kk], vf1[kk], o1); }
        }
        if (more) { LAS unsigned char* nb = lds + ((t + 1) & 1) * ABUF; *(LAS v4u*)(nb + kdst) = kreg; if (tid < 256) *(LAS v4u*)(nb + rdst) = rreg; VST(nb, vreg); }
        __syncthreads();
    }
    l_run += __shfl_xor(l_run, 32);
    if (hi == 0) wsf[r32] = 1.0f / l_run;
    LDS_WAIT();
#pragma unroll
    for (int g4 = 0; g4 < 4; ++g4) { const f32x4 il = *(const LAS f32x4*)(wsf + 8 * g4 + 4 * hi);
#pragma unroll
        for (int i = 0; i < 4; ++i) { const int r = 4 * g4 + i; const size_t m = (size_t)(rowbase + q0 + 32 * wave + crow(r, hi));
            MIX[m * 1024 + h * 64 + r32] = (bf16)f2bf(o0[r] * il[i]); MIX[m * 1024 + h * 64 + 32 + r32] = (bf16)f2bf(o1[r] * il[i]); } }
    LDS_WAIT();
    __syncthreads();
#undef VST
}
__device__ __forceinline__ void gla_fin_unit(const Args& a, int l, int unit, const LAS float* Sn, int tid) {
    const bf16* Z = (const bf16*)(a.ws + WS_Z); bf16* MIX = (bf16*)(a.ws + WS_MIX);
    const float* OI = (const float*)(a.ws + WS_OINTRA); const float* QT = (const float*)(a.ws + WS_QT);
    const int bh = unit >> 6, n = unit & 63, b = bh >> 2, h = bh & 3, m0 = b * SEQ + 64 * n;
    const int i = tid >> 3, g8 = tid & 7; const size_t m = (size_t)(m0 + i);
    const float* op = OI + m * 256 + h * 64 + g8 * 8;
    f32x4 oa = *(const f32x4*)op, ob = *(const f32x4*)(op + 4);
    const float* qp = QT + m * 128 + h * 32;
#pragma unroll 2
    for (int d4 = 0; d4 < 8; ++d4) { const f32x4 qv = *(const f32x4*)(qp + 4 * d4);
#pragma unroll
        for (int dd = 0; dd < 4; ++dd) { const int d = 4 * d4 + dd; oa += qv[dd] * *(const LAS f32x4*)(Sn + d * 64 + g8 * 8); ob += qv[dd] * *(const LAS f32x4*)(Sn + d * 64 + g8 * 8 + 4); } }
    float ss = (oa.x * oa.x + oa.y * oa.y) + (oa.z * oa.z + oa.w * oa.w) + (ob.x * ob.x + ob.y * ob.y) + (ob.z * ob.z + ob.w * ob.w);
    ss += __shfl_xor(ss, 1); ss += __shfl_xor(ss, 2); ss += __shfl_xor(ss, 4);
    const float rstd = rsqrtf(ss * (1.0f / 64.0f) + EPS);
    const float* ng = a.gla_ng + l * 64 + g8 * 8;
    const v4u rr = *(const v4u*)(Z + m * ZP + ZC_GR + h * 64 + g8 * 8);
    float o[8] = {oa.x, oa.y, oa.z, oa.w, ob.x, ob.y, ob.z, ob.w};
    v4u w;
#pragma unroll
    for (int j = 0; j < 4; ++j) { const float r0 = bflo(rr[j]), r1 = bfhi(rr[j]);
        w[j] = pk2(o[2 * j] * rstd * ng[2 * j] * silu_f(r0), o[2 * j + 1] * rstd * ng[2 * j + 1] * silu_f(r1)); }
    *(v4u*)(MIX + m * 1024 + 768 + h * 64 + g8 * 8) = w;
}
__device__ __forceinline__ void phase_attn(const Args& a, int l, LAS unsigned char* lds) {
    const int tid = ltid(), G = gridDim.x;
    {
        const float* SL = (const float*)(a.ws + WS_SLOC); const float* DEC = (const float*)(a.ws + WS_DEC);
        LAS float* Sn = (LAS float*)lds;
        const int vcu0 = (G % 8 == 0) ? (int)(blockIdx.x % 8) * (G / 8) + (int)(blockIdx.x / 8) : (int)blockIdx.x;
        for (int j = vcu0; j < 256; j += G) {
            const int bh = j >> 4, n0 = 4 * (j & 15), d = tid >> 4;
            f32x4 st = (f32x4){0.f, 0.f, 0.f, 0.f};
            int nb = 0;
#pragma unroll 1
            for (; nb + 16 <= n0; nb += 16) {
                f32x4 sv[16]; float dv[16];
#pragma unroll
                for (int k = 0; k < 16; ++k) { const size_t u = (size_t)(bh * 64 + nb + k); dv[k] = DEC[u * 32 + d]; sv[k] = *(const f32x4*)(SL + u * 2048 + 4 * tid); }
#pragma unroll
                for (int k = 0; k < 16; ++k) st = dv[k] * st + sv[k];
            }
#pragma unroll 1
            for (; nb < n0; nb += 4) {
                f32x4 sv[4]; float dv[4];
#pragma unroll
                for (int k = 0; k < 4; ++k) { const size_t u = (size_t)(bh * 64 + nb + k); dv[k] = DEC[u * 32 + d]; sv[k] = *(const f32x4*)(SL + u * 2048 + 4 * tid); }
#pragma unroll
                for (int k = 0; k < 4; ++k) st = dv[k] * st + sv[k];
            }
            for (int n = n0; n < n0 + 4; ++n) { const size_t u = (size_t)(bh * 64 + n);
                *(LAS f32x4*)(Sn + 4 * tid) = st;
                __syncthreads();
                gla_fin_unit(a, l, (int)u, Sn, tid);
                __syncthreads();
                st = DEC[u * 32 + d] * st + *(const f32x4*)(SL + u * 2048 + 4 * tid); }
        }
    }
    const int vcu = (G % 8 == 0) ? (int)(blockIdx.x % 8) * (G / 8) + (int)(blockIdx.x / 8) : (int)blockIdx.x;
    for (int p = vcu; p < 256; p += G) {
        const int bh = p >> 3, s = p & 7;
        attn_unit(a, bh >> 3, bh & 7, 15 - s, lds);
        attn_unit(a, bh >> 3, bh & 7, s, lds);
    }
}
__device__ __forceinline__ void down_fixup(const Args& a, int l, int pm) {
    const float* H = (const float*)(a.ws + WS_HALO); bf16* ACT = (bf16*)(a.ws + WS_ACT);
    const float* cw = a.conv_w + (size_t)l * 3 * 5632; const float* cb = a.conv_b + (size_t)l * 5632;
    const bool first = (pm & 15) == 0;
    const float* hc = H + (size_t)pm * 4 * 5632; const float* hp = H + (size_t)(pm - 1) * 4 * 5632;
    static_assert(2 * DFF == 11 * NTHR, "down_fixup: 11 elements per thread");
#pragma unroll 1
    for (int it0 = 0; it0 < 11; it0 += 4) {
        float res[4];
#pragma unroll
        for (int q = 0; q < 4; ++q) { const int it = it0 + q; res[q] = 0.f;
            if (it < 11) { const int e = (int)threadIdx.x + it * NTHR; const int rr = e / DFF, j = e % DFF; float zc[2];
#pragma unroll
                for (int part = 0; part < 2; ++part) { const int c = part * DFF + j;
                    const float zt = hc[rr * 5632 + c];
                    const float z1 = rr == 0 ? (first ? 0.f : hp[3 * 5632 + c]) : hc[c];
                    const float z2 = first ? 0.f : (rr == 0 ? hp[2 * 5632 + c] : hp[3 * 5632 + c]);
                    zc[part] = cb[c] + cw[2 * 5632 + c] * zt + cw[5632 + c] * z1 + cw[c] * z2; }
                res[q] = zc[0] * silu_f(zc[1]); } }
#pragma unroll
        for (int q = 0; q < 4; ++q) { const int it = it0 + q; if (it < 11) { const int e = (int)threadIdx.x + it * NTHR; const int rr = e / DFF, j = e % DFF; ACT[(size_t)(pm * 256 + rr) * DFF + j] = (bf16)f2bf(res[q]); } }
    }
}
__global__ void dbg_scan(const void* p, size_t n, int kind, unsigned* flag) {
    bool bad = false;
    for (size_t i = (size_t)blockIdx.x * blockDim.x + threadIdx.x; i < n; i += (size_t)gridDim.x * blockDim.x) {
        float v = kind ? ((const float*)p)[i] : bf2f(((const bf16*)p)[i]);
        if (!(fabsf(v) < 3e4f)) bad = true;
    }
    if (bad) atomicOr(flag, 1u);
}
__global__ void dbg_out(const unsigned* flags, int nf, float* out, size_t n) {
    int code = 0;
    for (int i = nf - 1; i >= 0; --i) if (flags[i]) code = i + 1;
    const float v = 1000.0f * code;
    for (size_t i = (size_t)blockIdx.x * blockDim.x + threadIdx.x; i < n; i += (size_t)gridDim.x * blockDim.x) out[i] = v;
}
#define XB_TMO      128
#define XB_XCNT(j)  (256  + 64 * (j))
#define XB_XSUB(j)  (1280 + 64 * (j))
#define XB_XGEN(j)  (2304 + 64 * (j))
#define XB_TOP      3328
#define XB_TOPGEN   3392
#define XCD_BAR_WORDS 3456
#define XB_SPIN_CAP (1u << 18)

__device__ __forceinline__ unsigned xb_ld(unsigned* p)              { return __hip_atomic_load(p, __ATOMIC_RELAXED, __HIP_MEMORY_SCOPE_AGENT); }
__device__ __forceinline__ unsigned xb_add(unsigned* p, unsigned v) { return __hip_atomic_fetch_add(p, v, __ATOMIC_RELAXED, __HIP_MEMORY_SCOPE_AGENT); }
__device__ __forceinline__ unsigned xb_xcc_id() { return (unsigned)__builtin_amdgcn_s_getreg((3 << 11) | 20) & 0xFu; }
#define XB_SPIN(cond, bar) do { unsigned _sp = 0; while (cond) { __builtin_amdgcn_s_sleep(1); \
    if ((++_sp & 255u) == 0u) { if (xb_ld(&(bar)[XB_TMO])) break; if (_sp > XB_SPIN_CAP) { atomicAdd(&(bar)[XB_TMO], 1u); break; } } } } while (0)

struct XcdBarrier {
    unsigned* bar; unsigned x;
    volatile LAS unsigned* st;
};

__device__ __forceinline__ XcdBarrier xcd_barrier_post(unsigned* bar, volatile LAS unsigned* st) {
    XcdBarrier b; b.bar = bar; b.x = xb_xcc_id(); b.st = st;
    if (threadIdx.x == 0) (void)xb_add(&bar[XB_XCNT(b.x)], 1u);
    return b;
}
__device__ __forceinline__ void xcd_barrier_complete(unsigned* bar, unsigned x, unsigned& nloc, unsigned& nx) {
    const unsigned G = gridDim.x * gridDim.y * gridDim.z;
    unsigned sum, cnt, mine, sp = 0u;
    for (;;) {
        sum = 0u; cnt = 0u; mine = 0u;
#pragma unroll
        for (unsigned j = 0; j < 16; ++j) { const unsigned c = xb_ld(&bar[XB_XCNT(j)]); sum += c; cnt += (c > 0u) ? 1u : 0u; mine = (j == x) ? c : mine; }
        if (sum == G) break;
        __builtin_amdgcn_s_sleep(1);
        if ((++sp & 255u) == 0u) { if (xb_ld(&bar[XB_TMO])) break; if (sp > XB_SPIN_CAP) { atomicAdd(&bar[XB_TMO], 1u); break; } }
    }
    nloc = mine > 0u ? mine : 1u; nx = cnt > 0u ? cnt : 1u;
}

__device__ __forceinline__ void xcd_barrier(const XcdBarrier& b) {
    asm volatile("s_waitcnt vmcnt(0)" ::: "memory");
    __syncthreads();
    if (threadIdx.x == 0) {
        unsigned* bar = b.bar;
        __builtin_amdgcn_s_waitcnt(0);
        unsigned nloc = b.st[0], nx = b.st[1];
        if (nloc == 0u) { xcd_barrier_complete(bar, b.x, nloc, nx); b.st[0] = nloc; b.st[1] = nx; }
        const unsigned old = xb_add(&bar[XB_XSUB(b.x)], 1u);
        const unsigned gen = old / nloc;
        if (old + 1u == (gen + 1u) * nloc) {
            __builtin_amdgcn_fence(__ATOMIC_RELEASE, "agent");
            asm volatile("s_waitcnt vmcnt(0)" ::: "memory");
            const unsigned og = xb_add(&bar[XB_TOP], 1u);
            const unsigned tg = og / nx;
            if (og + 1u == (tg + 1u) * nx) xb_add(&bar[XB_TOPGEN], 1u);
            else XB_SPIN(xb_ld(&bar[XB_TOPGEN]) == tg, bar);
            __builtin_amdgcn_fence(__ATOMIC_ACQUIRE, "agent");
            xb_add(&bar[XB_XGEN(b.x)], 1u);
            asm volatile("s_waitcnt vmcnt(0)" ::: "memory");
        } else {
            XB_SPIN(xb_ld(&bar[XB_XGEN(b.x)]) == gen, bar);
            __builtin_amdgcn_fence(__ATOMIC_ACQUIRE, "agent");
            asm volatile("s_waitcnt vmcnt(0)" ::: "memory");
        }
    }
    __syncthreads();
}

constexpr int N_PHASES = 2 + 6 * DEPTH;
constexpr size_t WS_CNT = WS_BAR + 16384, WS_XBUF = 316 * MiB;
#define IN(k) (a.ph_lo <= (k) && (k) < a.ph_hi)
#ifndef EXP_DOUBLE
#define EXP_DOUBLE 0
#endif
#define BARX() do { XcdBarrier xb_; { unsigned char* wsb_ = a.ws; asm volatile("" : "+s"(wsb_)); xb_.bar = (unsigned*)(wsb_ + WS_BAR); } xb_.x = xb_xcc_id(); xb_.st = (volatile LAS unsigned*)(lds + MISC_OFF); xcd_barrier(xb_); } while (0)
#define DBL(bit, stmt) do { if ((EXP_DOUBLE >> (bit)) & 1) { stmt; BARX(); } } while (0)
#define SEAM(k) do { if (IN(k) && IN((k) + 1)) { if ((k) == -1) grid.sync(); else { XcdBarrier xb_; { unsigned char* wsb_ = a.ws; asm volatile("" : "+s"(wsb_)); xb_.bar = (unsigned*)(wsb_ + WS_BAR); } xb_.x = xb_xcc_id(); xb_.st = (volatile LAS unsigned*)(lds + MISC_OFF); xcd_barrier(xb_); } } } while (0)
template <int L> __device__ __forceinline__ void layer_phases(const Args& a, LAS unsigned char* lds, cg::grid_group& grid) {
    constexpr int P = 2 + 6 * L;
    const int G = gridDim.x;
    bf16* XN = (bf16*)(a.ws + WS_XN); bf16* Zb = (bf16*)(a.ws + WS_Z); bf16* MIX = (bf16*)(a.ws + WS_MIX); bf16* ACT = (bf16*)(a.ws + WS_ACT);
    const float* modl = (const float*)(a.ws + WS_MOD) + (size_t)L * 4 * 6144;
    const bf16* wl = (const bf16*)(a.ws + WS_W + (size_t)L * W_LAYER_BYTES);
    const float* xin = (L == 0) ? a.x : a.out;
    float* xbuf = (float*)(a.ws + WS_XBUF); unsigned* cntb = (unsigned*)(a.ws + WS_CNT);
    if (IN(P + 0)) {
        pg8::Gemm g{XN, wl + WO_IN, M, ZP, D, D}; pg8::StaticOrder S; S.init(M, ZP, G, (int)blockIdx.x);
        pg8::EpiInStat E{Zb, ZP, (float*)(a.ws + WS_STATQ), (float*)(a.ws + WS_STATKV)};
        pg8::gemm_phase<pg8::EpiInStat, pg8::StaticOrder, true, true>(lds, g, S, E);
    }
    SEAM(P + 0);
    if (IN(P + 1)) phase_mid(a, L, lds);
    SEAM(P + 1);
    if (IN(P + 2)) phase_attn(a, L, lds);
    SEAM(P + 2);
    if (IN(P + 3)) {
        pg8::Gemm g{MIX, wl + WO_OUT, M, D, D, D}; pg8::StaticOrder S; S.init(M, D, G, (int)blockIdx.x);
        pg8::EpiResNorm E{xin, a.out, modl + 2048, a.norm_ffn_g + L * D, modl + 4096, modl + 3072, XN, nullptr, xbuf, cntb + (size_t)(2 * L) * 64 * 64};
        pg8::gemm_phase<pg8::EpiResNorm, pg8::StaticOrder, false, true>(lds, g, S, E);
    }
    SEAM(P + 3);
    if (IN(P + 4)) {
        pg8::Gemm g{XN, wl + WO_UP, M, 2 * DFF, D, D}; pg8::StaticOrder S; S.init(M, 2 * DFF, G, (int)blockIdx.x);
        pg8::EpiConv E{ACT, (float*)(a.ws + WS_HALO), a.conv_w + (size_t)L * 3 * 5632, a.conv_b + (size_t)L * 5632, (LAS float*)(lds + EX_OFF)};
        pg8::gemm_phase<pg8::EpiConv, pg8::StaticOrder, true, true>(lds, g, S, E);
    }
    SEAM(P + 4);
    if (IN(P + 5)) {
        pg8::StaticOrder S; S.init(M, D, G, (int)blockIdx.x);
        { pg8::Unit u; for (int i = 0; S.next(i, u); ++i) down_fixup(a, L, u.pm); }
        __builtin_amdgcn_fence(__ATOMIC_RELEASE, "agent"); __syncthreads(); __builtin_amdgcn_fence(__ATOMIC_ACQUIRE, "agent");
        pg8::Gemm g{ACT, wl + WO_DN, M, D, DFF, DFF};
        if (L < DEPTH - 1) {
            pg8::EpiResNorm E{a.out, a.out, modl + 5120, a.norm_mix_g + (L + 1) * D, modl + 4 * 6144 + 1024, modl + 4 * 6144, XN, nullptr, xbuf, cntb + (size_t)(2 * L + 1) * 64 * 64};
            pg8::gemm_phase<pg8::EpiResNorm, pg8::StaticOrder, false, true>(lds, g, S, E);
        } else {
            pg8::EpiResNorm E{a.out, nullptr, modl + 5120, a.final_g, nullptr, nullptr, nullptr, a.out, xbuf, cntb + (size_t)(2 * L + 1) * 64 * 64};
            pg8::gemm_phase<pg8::EpiResNorm, pg8::StaticOrder, false, true>(lds, g, S, E);
        }
    }
    if (L < DEPTH - 1) SEAM(P + 5);
}
__global__ void __launch_bounds__(NTHR, 2) mk_fwd(Args a) {
    extern __shared__ __attribute__((aligned(16))) unsigned char lds_raw[];
    LAS unsigned char* lds = (LAS unsigned char*)lds_raw;
    cg::grid_group grid = cg::this_grid();
    volatile LAS unsigned* misc = (volatile LAS unsigned*)(lds + MISC_OFF);
    if (threadIdx.x < 16) misc[threadIdx.x] = 0u;
    __syncthreads();
    (void)xcd_barrier_post((unsigned*)(a.ws + WS_BAR), misc);
    if (a.ph_lo < 0) grid.sync();
    if (IN(0)) phase_prologue(a, lds);
    SEAM(0);
    if (IN(1)) phase_norm(a.x, a.norm_mix_g, (const float*)(a.ws + WS_MOD), 0, 1024, (bf16*)(a.ws + WS_XN));
    SEAM(1);
    layer_phases<0>(a, lds, grid);
    layer_phases<1>(a, lds, grid);
    layer_phases<2>(a, lds, grid);
    layer_phases<3>(a, lds, grid);
}

#ifndef MK_MULTI
#define MK_MULTI 0
#endif
extern "C" void kernel_launch(void* const* d_in, const int* in_sizes, int n_in, void* d_out, int out_size, void* d_ws, size_t ws_size, hipStream_t stream) {
    static int grid = 0;
    if (grid == 0) {
        if (n_in != 25 || out_size != M * D || ws_size < WS_XBUF + MiB) { fprintf(stderr, "kernel_launch: unexpected shapes: n_in %d out %d ws %zu (need %zu)\n", n_in, out_size, ws_size, (size_t)WS_END); grid = -1; return; }
        int dev = 0, cus = 0, per_cu = 0;
        (void)hipGetDevice(&dev);
        (void)hipDeviceGetAttribute(&cus, hipDeviceAttributeMultiprocessorCount, dev);
        if (hipFuncSetAttribute((const void*)mk_fwd, hipFuncAttributeMaxDynamicSharedMemorySize, LDS_BYTES) != hipSuccess) { fprintf(stderr, "kernel_launch: hipFuncSetAttribute failed\n"); grid = -1; return; }
        (void)hipOccupancyMaxActiveBlocksPerMultiprocessor(&per_cu, (const void*)mk_fwd, NTHR, LDS_BYTES);
        (void)hipGetLastError();
        fprintf(stderr, "kernel_launch: cus %d per_cu %d ws %zu\n", cus, per_cu, ws_size);
        grid = cus;
        if (cus != 256) { fprintf(stderr, "kernel_launch: built for a 256-CU device (one 256x256 unit per workgroup in the fused-norm GEMM phases); found %d CUs, nothing launched\n", cus); grid = -1; return; }
    }
    if (grid < 0) return;
    if (hipMemsetAsync((unsigned char*)d_ws + WS_BAR, 0, 16384 + 8 * 64 * 256, stream) != hipSuccess) { fprintf(stderr, "kernel_launch: memset failed\n"); return; }
    Args a{};
    a.x = (const float*)d_in[0]; a.c = (const float*)d_in[1]; a.pos = (const int*)d_in[2];
    a.mod_w = (const float*)d_in[3]; a.mod_b = (const float*)d_in[4]; a.norm_mix_g = (const float*)d_in[5]; a.norm_ffn_g = (const float*)d_in[6]; a.w_in = (const float*)d_in[7];
    a.q_norm_g = (const float*)d_in[8]; a.kv_norm_g = (const float*)d_in[9]; a.w_uq = (const float*)d_in[10]; a.w_ukv = (const float*)d_in[11];
    a.sg_ln_g = (const float*)d_in[12]; a.sg_ln_b = (const float*)d_in[13]; a.sg_w_s = (const float*)d_in[14]; a.sg_b_s = (const float*)d_in[15];
    a.gla_w2 = (const float*)d_in[16]; a.gla_bg = (const float*)d_in[17]; a.gla_ng = (const float*)d_in[18]; a.w_out = (const float*)d_in[19];
    a.w_up = (const float*)d_in[20]; a.conv_w = (const float*)d_in[21]; a.conv_b = (const float*)d_in[22]; a.w_down = (const float*)d_in[23]; a.final_g = (const float*)d_in[24];
    a.out = (float*)d_out; a.ws = (unsigned char*)d_ws;
#ifdef DBG_PH
    a.ph_lo = 0; a.ph_hi = DBG_PH;
    { void* args[] = {&a}; hipError_t e = hipLaunchCooperativeKernel((const void*)mk_fwd, dim3(grid), dim3(NTHR), args, LDS_BYTES, stream); if (e != hipSuccess) fprintf(stderr, "coop fail %s\n", hipGetErrorString(e)); }
    unsigned* flags = (unsigned*)((unsigned char*)d_ws + 7 * MiB);
    hipMemsetAsync(flags, 0, 256, stream);
    struct B { size_t off; size_t n; int kind; };
    const B bufs[] = { {WS_MOD, 4 * 4 * 6144, 1}, {WS_W, 11862016, 0}, {WS_XN, (size_t)M * D, 0}, {WS_Z, (size_t)M * ZP, 0}, {WS_Q, (size_t)M * 768, 0}, {WS_KN, (size_t)M * 512, 0},
        {WS_VT, (size_t)M * 512, 0}, {WS_KR, (size_t)M * 32, 0}, {WS_OINTRA, (size_t)M * 256, 1}, {WS_QT, (size_t)M * 128, 1}, {WS_SLOC, (size_t)1024 * 2048, 1}, {WS_DEC, 1024 * 32, 1},
        {WS_MIX, (size_t)M * D, 0} };
    const int nb = sizeof(bufs) / sizeof(bufs[0]);
    for (int i = 0; i < nb; ++i) hipLaunchKernelGGL(dbg_scan, dim3(1024), dim3(256), 0, stream, (const void*)((unsigned char*)d_ws + bufs[i].off), bufs[i].n, bufs[i].kind, flags + i);
    hipLaunchKernelGGL(dbg_scan, dim3(1024), dim3(256), 0, stream, (const void*)d_out, (size_t)M * D, 1, flags + nb);
    hipLaunchKernelGGL(dbg_out, dim3(1024), dim3(256), 0, stream, (const unsigned*)flags, nb + 1, (float*)d_out, (size_t)M * D);
#elif MK_MULTI
    for (int ph = 0; ph < N_PHASES; ++ph) { a.ph_lo = ph; a.ph_hi = ph + 1; hipLaunchKernelGGL(mk_fwd, dim3(grid), dim3(NTHR), LDS_BYTES, stream, a); }
#else
    a.ph_lo = 0; a.ph_hi = N_PHASES;
    void* args[] = {&a};
    hipError_t e = hipLaunchCooperativeKernel((const void*)mk_fwd, dim3(grid), dim3(NTHR), args, LDS_BYTES, stream);
    if (e != hipSuccess) fprintf(stderr, "kernel_launch: cooperative launch failed: %s (grid %d)\n", hipGetErrorString(e), grid);
#endif
}
```
